# Optimizing an MI355X kernel written in HIP

```python
import math
import jax
import jax.numpy as jnp
from jax import lax
import numpy as np

D_MODEL = 1024
BATCH = 4
SEQ = 8192
DEPTH = 2

GRID_W = 64
CTX_LEN = 256
EPS = 1e-6

N_BRANCH = 4
W_MIX = D_MODEL // N_BRANCH

GLA_HEADS = 4
GLA_DK = W_MIX // GLA_HEADS
GLA_DV = W_MIX // GLA_HEADS
GLA_RANK = 16
GLA_TAU = 16.0
GLA_CHUNK = 64

S5_GROUP = 16
S5_GROUPS = W_MIX // S5_GROUP
S5_STATE = 64
S5_MAX_RE = -1e-4

HY_BANDS = 16
HY_EMB = 1 + 2 * HY_BANDS
HY_FFN = 64
HY_SHORT = 3
HY_DECAY_SHORT = 0.3
HY_DECAY_LONG = 1.5
HY_TARGET = 1e-2

RG_BLOCKS = 4
RG_BLOCK = W_MIX // RG_BLOCKS
RG_CONV = 4
RG_C = 8.0

D_FF = 2816
N_EXPERTS = 8
TOP_K = 2
D_EXPERT = 3584
N_DENSE = (DEPTH + 1) // 2
N_MOE = DEPTH // 2

IN_SIZES = (GLA_HEADS * GLA_DK, GLA_HEADS * GLA_DK, GLA_HEADS * GLA_DV, GLA_HEADS * GLA_DV,
            2 * GLA_RANK, W_MIX, 3 * W_MIX, W_MIX, W_MIX, N_BRANCH * D_MODEL)
IN_COLS = sum(IN_SIZES)

kernel_name = "hybrid_dit_gla_s5_hyena_rglru_moe"


def rmsnorm(x, g):
    x32 = x.astype(jnp.float32)
    y = x32 * lax.rsqrt(jnp.mean(x32 * x32, axis=-1, keepdims=True) + EPS)
    return (y * g.astype(jnp.float32)).astype(x.dtype)


def modulate(h, shift, scale):
    return (h * (1 + scale) + shift).astype(h.dtype)


def adaln(cond, w, b):
    return jax.nn.silu(cond) @ w + b


def split_cols(p):
    out, start = [], 0
    for n in IN_SIZES:
        out.append(p[..., start:start + n])
        start += n
    return out


def grid_pos_embed(n_tokens, dim):
    rows = n_tokens // GRID_W
    q = dim // 4
    omega = 1.0 / (10000.0 ** (jnp.arange(q, dtype=jnp.float32) / q))
    r = jnp.arange(rows, dtype=jnp.float32)[:, None] * omega
    cc = jnp.arange(GRID_W, dtype=jnp.float32)[:, None] * omega
    er = jnp.concatenate([jnp.sin(r), jnp.cos(r)], axis=-1)
    ec = jnp.concatenate([jnp.sin(cc), jnp.cos(cc)], axis=-1)
    emb = jnp.concatenate([jnp.broadcast_to(er[:, None], (rows, GRID_W, dim // 2)),
                           jnp.broadcast_to(ec[None], (rows, GRID_W, dim // 2))], axis=-1)
    return emb.reshape(rows * GRID_W, dim)


def dwconv(x, w, pad_l, pad_r):
    n = x.shape[1]
    xp = jnp.pad(x, ((0, 0), (pad_l, pad_r), (0, 0)))
    return sum(xp[:, k:k + n] * w[k] for k in range(w.shape[0]))


def to_heads(t, n):
    b, n_tok, w = t.shape
    return t.reshape(b, n_tok, n, w // n).transpose(0, 2, 1, 3)


def _lin_combine(e1, e2):
    a1, b1 = e1
    a2, b2 = e2
    return a1 * a2, a2 * b1 + b2


def linear_scan(a, b, h0):
    b = b.at[:, 0].add(a[:, 0] * h0)
    _, h = lax.associative_scan(_lin_combine, (a, b), axis=1)
    return h


def gla_chunked(q, k, v, la, s0):
    b_, h_, n_tok, dk = q.shape
    dv = v.shape[-1]
    n_ch = n_tok // GLA_CHUNK
    q = q.reshape(b_, h_, n_ch, GLA_CHUNK, dk)
    k = k.reshape(b_, h_, n_ch, GLA_CHUNK, dk)
    v = v.reshape(b_, h_, n_ch, GLA_CHUNK, dv)
    cum = jnp.cumsum(la.reshape(b_, h_, n_ch, GLA_CHUNK, dk), axis=3)
    cum_last = cum[:, :, :, -1:, :]
    q_in = q * jnp.exp(cum)
    k_in = k * jnp.exp(-cum)
    k_out = k * jnp.exp(cum_last - cum)
    mask = jnp.tril(jnp.ones((GLA_CHUNK, GLA_CHUNK), dtype=bool))
    att = jnp.where(mask, jnp.einsum('bhnid,bhnjd->bhnij', q_in, k_in), 0.0)
    o_intra = jnp.einsum('bhnij,bhnjv->bhniv', att, v)
    d_state = jnp.einsum('bhnjd,bhnjv->bhndv', k_out, v)
    decay = jnp.exp(cum_last[:, :, :, 0, :])

    def step(s, inp):
        dec, ds = inp
        return dec[..., None] * s + ds, s

    s_fin, s_in = lax.scan(step, s0, (jnp.moveaxis(decay, 2, 0), jnp.moveaxis(d_state, 2, 0)))
    s_in = jnp.moveaxis(s_in, 0, 2)
    o_inter = jnp.einsum('bhnid,bhndv->bhniv', q_in, s_in)
    return (o_intra + o_inter).reshape(b_, h_, n_tok, dv), s_fin


def gla_mixer(q, k, v, og, gdn, w_up, b_up, s0):
    f32 = jnp.float32
    b_, n_tok, _ = q.shape
    qh = to_heads(q.astype(f32), GLA_HEADS) * (GLA_DK ** -0.5)
    kh = to_heads(k.astype(f32), GLA_HEADS)
    vh = to_heads(v.astype(f32), GLA_HEADS)
    g_dirs = jnp.split(gdn.astype(f32), 2, axis=-1)
    o = 0.0
    finals = []
    for d in range(2):
        la = jax.nn.log_sigmoid(g_dirs[d] @ w_up[d].astype(f32) + b_up[d].astype(f32)) / GLA_TAU
        la = to_heads(la, GLA_HEADS)
        if d == 0:
            od, sd = gla_chunked(qh, kh, vh, la, s0[d])
        else:
            od, sd = gla_chunked(*(jnp.flip(t, 2) for t in (qh, kh, vh, la)), s0[d])
            od = jnp.flip(od, 2)
        o = o + od
        finals.append(sd)
    o = o * lax.rsqrt(jnp.mean(o * o, axis=-1, keepdims=True) + EPS)
    o = o.transpose(0, 2, 1, 3).reshape(b_, n_tok, GLA_HEADS * GLA_DV)
    out = o * jax.nn.silu(og.astype(f32))
    return out.astype(q.dtype), jnp.stack(finals)


def s5_mixer(u, lam_re, lam_im, log_dt, b_re, b_im, c_re, c_im, d_skip, w_glu, b_glu, s0):
    f32 = jnp.float32
    b_, n_tok, _ = u.shape
    ug = u.astype(f32).reshape(b_, n_tok, S5_GROUPS, S5_GROUP)
    y = ug * d_skip.astype(f32)
    finals = []
    for d in range(2):
        lam = lax.complex(jnp.minimum(lam_re[d].astype(f32), S5_MAX_RE), lam_im[d].astype(f32))
        dt = jnp.exp(log_dt[d].astype(f32))[:, None]
        lbar = jnp.exp(lam * dt)
        bbar = ((lbar - 1.0) / lam)[..., None] * lax.complex(b_re[d].astype(f32), b_im[d].astype(f32))
        cmat = lax.complex(c_re[d].astype(f32), c_im[d].astype(f32))
        src = ug if d == 0 else jnp.flip(ug, 1)
        bu = jnp.einsum('blgh,gph->blgp', src.astype(jnp.complex64), bbar)
        a = jnp.broadcast_to(lbar[None, None], (1, n_tok) + lbar.shape)
        h = linear_scan(a, bu, s0[d])
        finals.append(h[:, -1])
        yd = jnp.einsum('blgp,ghp->blgh', h, cmat).real
        y = y + (yd if d == 0 else jnp.flip(yd, 1))
    y = y.reshape(b_, n_tok, W_MIX)
    g = jax.nn.gelu(y)
    out = g * jax.nn.sigmoid(g @ w_glu.astype(f32) + b_glu.astype(f32))
    return out.astype(u.dtype), jnp.stack(finals)


def hyena_filters(n_tok, w1, b1, w2, b2, w3, freq):
    f32 = jnp.float32
    t = jnp.arange(n_tok, dtype=f32)[:, None]
    bands = jnp.linspace(1e-4, HY_BANDS - 1, HY_BANDS, dtype=f32)[None]
    ang = 2.0 * math.pi * bands * t / n_tok
    z = jnp.concatenate([t / n_tok, jnp.cos(ang), jnp.sin(ang)], axis=-1)
    fr = freq.astype(f32)
    h = jnp.sin(fr * (z @ w1.astype(f32) + b1.astype(f32)))
    h = jnp.sin(fr * (h @ w2.astype(f32) + b2.astype(f32)))
    h = h @ w3.astype(f32)
    t01 = t / max(n_tok - 1, 1)
    deltas = jnp.abs(jnp.linspace(math.log(HY_TARGET) / HY_DECAY_SHORT,
                                  math.log(HY_TARGET) / HY_DECAY_LONG, W_MIX, dtype=f32))
    h = h * jnp.exp(-t01 * jnp.tile(deltas, 2))
    return h / (jnp.sum(jnp.abs(h), axis=0, keepdims=True) + EPS)


def hyena_mixer(p, w_short, w1, b1, w2, b2, w3, freq, bias):
    f32 = jnp.float32
    n_tok = p.shape[1]
    pc = dwconv(p.astype(f32), w_short.astype(f32), 1, 1)
    v, x0, x1 = jnp.split(pc, 3, axis=-1)
    hf, hb = jnp.split(hyena_filters(n_tok, w1, b1, w2, b2, w3, freq), 2, axis=-1)
    n_fft = 2 * n_tok
    h_freq = jnp.fft.rfft(hf, n=n_fft, axis=0) + jnp.conj(jnp.fft.rfft(hb, n=n_fft, axis=0))
    z = x1 * v
    conv = jnp.fft.irfft(jnp.fft.rfft(z, n=n_fft, axis=1) * h_freq, n=n_fft, axis=1)[:, :n_tok]
    y = x0 * (conv + z * bias.astype(f32))
    return y.astype(p.dtype)


def rglru_mixer(xr, gate, w_conv, w_a, b_a, w_x, b_x, lam, s0):
    f32 = jnp.float32
    b_, n_tok, _ = xr.shape
    xc = dwconv(xr.astype(f32), w_conv.astype(f32), 2, 1)
    xb = xc.reshape(b_, n_tok, RG_BLOCKS, RG_BLOCK)
    y = 0.0
    finals = []
    for d in range(2):
        src = xb if d == 0 else jnp.flip(xb, 1)
        r = jax.nn.sigmoid(jnp.einsum('blhi,hij->blhj', src, w_a[d].astype(f32)) + b_a[d].astype(f32))
        i = jax.nn.sigmoid(jnp.einsum('blhi,hij->blhj', src, w_x[d].astype(f32)) + b_x[d].astype(f32))
        log_a = -RG_C * r * jax.nn.softplus(-lam[d].astype(f32).reshape(RG_BLOCKS, RG_BLOCK))
        a = jnp.exp(log_a)
        bt = jnp.sqrt(-jnp.expm1(2.0 * log_a)) * (i * src)
        h = linear_scan(a, bt, s0[d])
        finals.append(h[:, -1])
        y = y + (h if d == 0 else jnp.flip(h, 1))
    y = y.reshape(b_, n_tok, W_MIX) * jax.nn.gelu(gate.astype(f32))
    return y.astype(xr.dtype), jnp.stack(finals)


def merge_branches(branches, gates, w_branch, w_out):
    gk = jnp.split(gates, N_BRANCH, axis=-1)
    y = 0.0
    for k in range(N_BRANCH):
        y = y + jax.nn.sigmoid(gk[k]) * (branches[k] @ w_branch[k])
    return y @ w_out


def swiglu(h, w_gu, w_down):
    g, u = jnp.split(h @ w_gu, 2, axis=-1)
    return (jax.nn.silu(g) * u) @ w_down


def moe_swiglu(h, router, router_b, w_gu, w_down):
    shp = h.shape
    ht = h.reshape(-1, shp[-1])
    logits = ht.astype(jnp.float32) @ router.astype(jnp.float32) + router_b.astype(jnp.float32)
    top_v, top_i = lax.top_k(logits, TOP_K)
    w = jax.nn.softmax(top_v, axis=-1)
    gates = jnp.sum(jax.nn.one_hot(top_i, N_EXPERTS, dtype=jnp.float32) * w[..., None], axis=1)
    y = jnp.zeros_like(ht)
    for e in range(N_EXPERTS):
        y = y + gates[:, e:e + 1].astype(ht.dtype) * swiglu(ht, w_gu[e], w_down[e])
    return y.reshape(shp)


def channel_mix(h, layer, ffn_w_gu, ffn_w_down, moe_router, moe_router_b, moe_w_gu, moe_w_down):
    j = layer // 2
    if layer % 2 == 0:
        return swiglu(h, ffn_w_gu[j], ffn_w_down[j])
    return moe_swiglu(h, moe_router[j], moe_router_b[j], moe_w_gu[j], moe_w_down[j])


def setup_inputs(seed: int = 0) -> dict:
    key = jax.random.key(seed)
    ks = iter(jax.random.split(key, 64))
    f32 = jnp.float32

    def nrm(shape, scale):
        return jax.random.normal(next(ks), shape, f32) * scale

    def uni(shape, lo, hi):
        return jax.random.uniform(next(ks), shape, f32, lo, hi)

    l2 = (DEPTH, 2)
    x = nrm((BATCH, SEQ, D_MODEL), 1.0)
    c = nrm((BATCH, D_MODEL), 1.0)
    ctx = nrm((BATCH, CTX_LEN, D_MODEL), 1.0)
    c_ctx = nrm((D_MODEL,), 1.0)
    mod_w = nrm((DEPTH, D_MODEL, 6 * D_MODEL), 0.5 * D_MODEL ** -0.5)
    mod_b = nrm((DEPTH, 6 * D_MODEL), 0.02)
    norm1_g = 1.0 + nrm((DEPTH, D_MODEL), 0.02)
    norm2_g = 1.0 + nrm((DEPTH, D_MODEL), 0.02)
    w_in = nrm((DEPTH, D_MODEL, IN_COLS), D_MODEL ** -0.5)
    gla_w_up = nrm(l2 + (GLA_RANK, W_MIX), GLA_RANK ** -0.5)
    gla_b_up = nrm(l2 + (W_MIX,), 0.1)
    n_idx = jnp.arange(S5_STATE, dtype=f32)
    s5_lam_re = -0.5 + nrm(l2 + (S5_GROUPS, S5_STATE), 0.01)
    s5_lam_im = math.pi * n_idx + nrm(l2 + (S5_GROUPS, S5_STATE), 0.01)
    s5_log_dt = uni(l2 + (S5_GROUPS,), math.log(1e-3), math.log(1e-1))
    s5_b_re = nrm(l2 + (S5_GROUPS, S5_STATE, S5_GROUP), (2 * S5_GROUP) ** -0.5)
    s5_b_im = nrm(l2 + (S5_GROUPS, S5_STATE, S5_GROUP), (2 * S5_GROUP) ** -0.5)
    s5_c_re = nrm(l2 + (S5_GROUPS, S5_GROUP, S5_STATE), (2 * S5_STATE) ** -0.5)
    s5_c_im = nrm(l2 + (S5_GROUPS, S5_GROUP, S5_STATE), (2 * S5_STATE) ** -0.5)
    s5_d = nrm((DEPTH, S5_GROUPS, S5_GROUP), 0.5)
    s5_w_glu = nrm((DEPTH, W_MIX, W_MIX), W_MIX ** -0.5)
    s5_b_glu = nrm((DEPTH, W_MIX), 0.02)
    hy_w_short = nrm((DEPTH, HY_SHORT, 3 * W_MIX), HY_SHORT ** -0.5)
    hy_w1 = nrm((DEPTH, HY_EMB, HY_FFN), HY_EMB ** -0.5)
    hy_b1 = nrm((DEPTH, HY_FFN), 0.1)
    hy_w2 = nrm((DEPTH, HY_FFN, HY_FFN), HY_FFN ** -0.5)
    hy_b2 = nrm((DEPTH, HY_FFN), 0.1)
    hy_w3 = nrm((DEPTH, HY_FFN, 2 * W_MIX), HY_FFN ** -0.5)
    hy_freq = 1.0 + nrm((DEPTH, HY_FFN), 0.05)
    hy_bias = nrm((DEPTH, W_MIX), 0.1)
    rg_w_conv = nrm((DEPTH, RG_CONV, W_MIX), RG_CONV ** -0.5)
    rg_w_a = nrm(l2 + (RG_BLOCKS, RG_BLOCK, RG_BLOCK), RG_BLOCK ** -0.5)
    rg_b_a = nrm(l2 + (RG_BLOCKS, RG_BLOCK), 0.1)
    rg_w_x = nrm(l2 + (RG_BLOCKS, RG_BLOCK, RG_BLOCK), RG_BLOCK ** -0.5)
    rg_b_x = nrm(l2 + (RG_BLOCKS, RG_BLOCK), 0.1)
    a0 = uni(l2 + (W_MIX,), 0.9, 0.999)
    s_root = a0 ** (1.0 / RG_C)
    rg_lam = jnp.log(s_root) - jnp.log1p(-s_root)
    w_branch = nrm((DEPTH, N_BRANCH, W_MIX, D_MODEL), W_MIX ** -0.5)
    w_out = nrm((DEPTH, D_MODEL, D_MODEL), D_MODEL ** -0.5)
    ffn_w_gu = nrm((N_DENSE, D_MODEL, 2 * D_FF), D_MODEL ** -0.5)
    ffn_w_down = nrm((N_DENSE, D_FF, D_MODEL), D_FF ** -0.5)
    moe_router = nrm((N_MOE, D_MODEL, N_EXPERTS), D_MODEL ** -0.5)
    moe_router_b = nrm((N_MOE, N_EXPERTS), 0.01)
    moe_w_gu = nrm((N_MOE, N_EXPERTS, D_MODEL, 2 * D_EXPERT), D_MODEL ** -0.5)
    moe_w_down = nrm((N_MOE, N_EXPERTS, D_EXPERT, D_MODEL), D_EXPERT ** -0.5)
    final_g = 1.0 + nrm((D_MODEL,), 0.02)
    return {"x": x, "c": c, "ctx": ctx, "c_ctx": c_ctx, "mod_w": mod_w, "mod_b": mod_b,
            "norm1_g": norm1_g, "norm2_g": norm2_g, "w_in": w_in,
            "gla_w_up": gla_w_up, "gla_b_up": gla_b_up,
            "s5_lam_re": s5_lam_re, "s5_lam_im": s5_lam_im, "s5_log_dt": s5_log_dt,
            "s5_b_re": s5_b_re, "s5_b_im": s5_b_im, "s5_c_re": s5_c_re, "s5_c_im": s5_c_im,
            "s5_d": s5_d, "s5_w_glu": s5_w_glu, "s5_b_glu": s5_b_glu,
            "hy_w_short": hy_w_short, "hy_w1": hy_w1, "hy_b1": hy_b1, "hy_w2": hy_w2,
            "hy_b2": hy_b2, "hy_w3": hy_w3, "hy_freq": hy_freq, "hy_bias": hy_bias,
            "rg_w_conv": rg_w_conv, "rg_w_a": rg_w_a, "rg_b_a": rg_b_a, "rg_w_x": rg_w_x,
            "rg_b_x": rg_b_x, "rg_lam": rg_lam, "w_branch": w_branch, "w_out": w_out,
            "ffn_w_gu": ffn_w_gu, "ffn_w_down": ffn_w_down, "moe_router": moe_router,
            "moe_router_b": moe_router_b, "moe_w_gu": moe_w_gu, "moe_w_down": moe_w_down,
            "final_g": final_g}


def reference(x, c, ctx, c_ctx, mod_w, mod_b, norm1_g, norm2_g, w_in, gla_w_up, gla_b_up,
              s5_lam_re, s5_lam_im, s5_log_dt, s5_b_re, s5_b_im, s5_c_re, s5_c_im, s5_d,
              s5_w_glu, s5_b_glu, hy_w_short, hy_w1, hy_b1, hy_w2, hy_b2, hy_w3, hy_freq,
              hy_bias, rg_w_conv, rg_w_a, rg_b_a, rg_w_x, rg_b_x, rg_lam, w_branch, w_out,
              ffn_w_gu, ffn_w_down, moe_router, moe_router_b, moe_w_gu, moe_w_down, final_g):
    f32 = jnp.float32
    n_b, n_lat, _ = x.shape
    x = x + grid_pos_embed(n_lat, D_MODEL).astype(x.dtype)[None]
    y_ctx = ctx
    for l in range(DEPTH):
        last = l == DEPTH - 1
        m_lat = jnp.split(adaln(c, mod_w[l], mod_b[l])[:, None, :], 6, axis=-1)
        m_ctx = jnp.split(adaln(c_ctx, mod_w[l], mod_b[l])[None, None, :], 6, axis=-1)

        h_lat = modulate(rmsnorm(x, norm1_g[l]), m_lat[0], m_lat[1])
        h_ctx = modulate(rmsnorm(y_ctx, norm1_g[l]), m_ctx[0], m_ctx[1])
        p_lat = split_cols(h_lat @ w_in[l])
        p_ctx = split_cols(h_ctx @ w_in[l])
        gla_p = (gla_w_up[l], gla_b_up[l])
        s5_p = (s5_lam_re[l], s5_lam_im[l], s5_log_dt[l], s5_b_re[l], s5_b_im[l],
                s5_c_re[l], s5_c_im[l], s5_d[l], s5_w_glu[l], s5_b_glu[l])
        hy_p = (hy_w_short[l], hy_w1[l], hy_b1[l], hy_w2[l], hy_b2[l], hy_w3[l], hy_freq[l], hy_bias[l])
        rg_p = (rg_w_conv[l], rg_w_a[l], rg_b_a[l], rg_w_x[l], rg_b_x[l], rg_lam[l])

        gla_c, gla_state = gla_mixer(*p_ctx[0:5], *gla_p,
                                     jnp.zeros((2, n_b, GLA_HEADS, GLA_DK, GLA_DV), f32))
        gla_l, _ = gla_mixer(*p_lat[0:5], *gla_p, gla_state)
        s5_c, s5_state = s5_mixer(p_ctx[5], *s5_p,
                                  jnp.zeros((2, n_b, S5_GROUPS, S5_STATE), jnp.complex64))
        s5_l, _ = s5_mixer(p_lat[5], *s5_p, s5_state)
        rg_c, rg_state = rglru_mixer(p_ctx[7], p_ctx[8], *rg_p,
                                     jnp.zeros((2, n_b, RG_BLOCKS, RG_BLOCK), f32))
        rg_l, _ = rglru_mixer(p_lat[7], p_lat[8], *rg_p, rg_state)
        hy_l = hyena_mixer(p_lat[6], *hy_p)

        x = x + m_lat[2] * merge_branches((gla_l, s5_l, hy_l, rg_l), p_lat[9], w_branch[l], w_out[l])
        if not last:
            hy_c = hyena_mixer(p_ctx[6], *hy_p)
            y_ctx = y_ctx + m_ctx[2] * merge_branches((gla_c, s5_c, hy_c, rg_c), p_ctx[9],
                                                      w_branch[l], w_out[l])

        h2_lat = modulate(rmsnorm(x, norm2_g[l]), m_lat[3], m_lat[4])
        x = x + m_lat[5] * channel_mix(h2_lat, l, ffn_w_gu, ffn_w_down, moe_router,
                                       moe_router_b, moe_w_gu, moe_w_down)
        if not last:
            h2_ctx = modulate(rmsnorm(y_ctx, norm2_g[l]), m_ctx[3], m_ctx[4])
            y_ctx = y_ctx + m_ctx[5] * channel_mix(h2_ctx, l, ffn_w_gu, ffn_w_down, moe_router,
                                                   moe_router_b, moe_w_gu, moe_w_down)
    return rmsnorm(x, final_g)
```

```cpp
#include <hip/hip_runtime.h>
#include <cstdio>
#include <cstdint>

#define LAS __attribute__((address_space(3)))
#define GAS __attribute__((address_space(1)))
typedef unsigned short bf16;
typedef float f32x4 __attribute__((ext_vector_type(4)));
typedef float f32x16 __attribute__((ext_vector_type(16)));
typedef float f32x2 __attribute__((ext_vector_type(2)));
typedef unsigned u32x4 __attribute__((ext_vector_type(4)));
typedef unsigned u32x2 __attribute__((ext_vector_type(2)));
typedef short bf16x8 __attribute__((ext_vector_type(8)));

__device__ __forceinline__ unsigned f2bf(float f) { unsigned u = __float_as_uint(f); return (u + 0x7fffu + ((u >> 16) & 1u)) >> 16; }
__device__ __forceinline__ float bf2f(unsigned b) { return __uint_as_float(b << 16); }
__device__ __forceinline__ float bflo(unsigned w) { return __uint_as_float(w << 16); }
__device__ __forceinline__ float bfhi(unsigned w) { return __uint_as_float(w & 0xffff0000u); }
__device__ __forceinline__ unsigned pk2(float lo, float hi) { return f2bf(lo) | (f2bf(hi) << 16); }
__device__ __forceinline__ unsigned pack4_fp8(float a, float b, float c, float d) {
    a = fminf(fmaxf(a, -448.f), 448.f); b = fminf(fmaxf(b, -448.f), 448.f); c = fminf(fmaxf(c, -448.f), 448.f); d = fminf(fmaxf(d, -448.f), 448.f);
    int w = 0; w = __builtin_amdgcn_cvt_pk_fp8_f32(a, b, w, false); w = __builtin_amdgcn_cvt_pk_fp8_f32(c, d, w, true); return (unsigned)w; }
__device__ __forceinline__ float sigmoid_fast(float x) { return __builtin_amdgcn_rcpf(1.0f + __expf(-x)); }
__device__ __forceinline__ float sigmoid_acc(float x) { return 1.0f / (1.0f + expf(-x)); }
__device__ __forceinline__ float silu_acc(float x) { return x / (1.0f + expf(-x)); }
__device__ __forceinline__ float gelu_tanh(float x) { const float u = 0.7978845608028654f * (x + 0.044715f * x * x * x); const float t = 1.0f - 2.0f / (expf(2.0f * u) + 1.0f); return 0.5f * x * (1.0f + t); }
__device__ __forceinline__ float gelu_tanh_fast(float x) { const float u = 0.7978845608028654f * (x + 0.044715f * x * x * x); const float t = 1.0f - 2.0f * __builtin_amdgcn_rcpf(__expf(2.0f * u) + 1.0f); return 0.5f * x * (1.0f + t); }
__device__ __forceinline__ int tidx() { int t = threadIdx.x; asm volatile("" : "+v"(t)); return t; }
__device__ __forceinline__ int bidx() { int t = blockIdx.x; asm volatile("" : "+s"(t)); return t; }
__device__ __forceinline__ int gdim() { int t = gridDim.x; asm volatile("" : "+s"(t)); return t; }
__device__ __forceinline__ float wave_sum(float v) {
#pragma unroll
    for (int o = 1; o < 64; o <<= 1) v += __shfl_xor(v, o);
    return v;
}

namespace pg8 {
constexpr int BM = 256, BK = 64, HALF = 128, HTB = HALF * BK * 2, STAGE_BYTES = 8 * HTB, NXCD = 8, WGM = 8;
__host__ __device__ __forceinline__ int lds_byte(int r, int c) { const int st = (r >> 4) * 2 + (c >> 5), rr = r & 15, cc = c & 31, ob = rr * 64 + cc * 2; return st * 1024 + (ob ^ (((ob >> 9) & 1) << 5)); }
__host__ __device__ __forceinline__ void stage_rc(int b, int& R, int& C) { const int st = b / 1024, sb = b % 1024, swz = sb ^ (((sb >> 9) & 1) << 5); R = (st >> 1) * 16 + swz / 64; C = (st & 1) * 32 + (swz % 64) / 2; }
__host__ __device__ __forceinline__ int perm32(int rho) { const int n = rho >> 4, i = rho & 15; return 8 * (i >> 2) + 4 * n + (i & 3); }

struct Unit { int pa, pb, pm, pn, aux, k0, nkt, split; };
struct Gemm { const bf16* A; const bf16* Bt; int lda, ldb, K; };

struct StaticOrder {
    int nM, nN, nwg, G, c;
    __device__ void init(int nM_, int nN_, int G_, int c_) { nM = nM_; nN = nN_; nwg = nM * nN; G = G_; c = c_; }
    __device__ bool next(int i, Unit& u) const {
        const long L = (long)i * G + c; if (L >= nwg) return false;
        int wgid = (int)L; { const int q = nwg / NXCD, r = nwg % NXCD, xcd = wgid % NXCD, off = wgid / NXCD; wgid = (xcd < r ? xcd * (q + 1) : r * (q + 1) + (xcd - r) * q) + off; }
        const int nig = WGM * nN, gid = wgid / nig, fm = gid * WGM, gsz = (nM - fm) < WGM ? (nM - fm) : WGM;
        u.pm = fm + ((wgid % nig) % gsz); u.pn = (wgid % nig) / gsz; u.pa = u.pm; u.pb = u.pn; u.aux = 0; u.k0 = 0; u.nkt = 0; u.split = 0; return true;
    }
};
__device__ __forceinline__ unsigned cvt_pk_bf16(float lo, float hi) { unsigned r; asm volatile("v_cvt_pk_bf16_f32 %0, %1, %2" : "=v"(r) : "v"(lo), "v"(hi)); return r; }

#ifndef GEMM_SP2
#define GEMM_SP2 true
#endif
typedef int i32x8 __attribute__((ext_vector_type(8)));
typedef short s16x16 __attribute__((ext_vector_type(16)));
typedef int i32x4 __attribute__((ext_vector_type(4)));
template <bool F8> struct Frag;
template <> struct Frag<false> { bf16x8 p0, p1; };
template <> struct Frag<true> { i32x8 v; };
template <bool F8> __device__ __forceinline__ void frag_load(Frag<F8>& f, const LAS unsigned char* p) {
    if constexpr (F8) { f.v.lo = *(const LAS i32x4*)p; f.v.hi = *(const LAS i32x4*)(p + 1024); }
    else { f.p0 = *(const LAS bf16x8*)p; f.p1 = *(const LAS bf16x8*)(p + 1024); }
}
template <bool F8> __device__ __forceinline__ f32x4 mma_pair(const Frag<F8>& b, const Frag<F8>& a, f32x4 c) {
    if constexpr (F8) {
#if defined(__HIP_DEVICE_COMPILE__)
        asm volatile("v_mfma_f32_16x16x128_f8f6f4 %0, %1, %2, %0" : "+v"(c) : "v"(b.v), "v"(a.v));
#endif
        return c; }
    else { c = __builtin_amdgcn_mfma_f32_16x16x32_bf16(b.p0, a.p0, c, 0, 0, 0); return __builtin_amdgcn_mfma_f32_16x16x32_bf16(b.p1, a.p1, c, 0, 0, 0); }
}
template <class Epi, class Sched, bool F8 = false, bool ALIGN_EPI = true, bool SP2 = GEMM_SP2>
__device__ __forceinline__ void gemm_phase(LAS unsigned char* lds, const Gemm g, const Sched& S, const Epi& E) {
    const int tid = tidx(), wid = __builtin_amdgcn_readfirstlane(tid >> 6), lane = tid & 63, wr = wid >> 2, wc = wid & 3, fr = lane & 15, fq = lane >> 4;
    const int K = g.K, ntall = K / BK;
    unsigned voffA[2], voffB[2];
#pragma unroll
    for (int i = 0; i < 2; ++i) { int R, C; stage_rc(tid * 16 + i * 8192, R, C); const int Rb = Epi::PERM ? ((R & ~31) + perm32(R & 31)) : R;
        voffA[i] = (unsigned)(R * g.lda + C) * 2u; voffB[i] = (unsigned)(Rb * g.ldb + C) * 2u; }
    const size_t kstep = (size_t)(BK * 2);
    const size_t hstepA = (size_t)HALF * g.lda * 2, hstepB = (size_t)HALF * g.ldb * 2;
    const size_t tstepA = 2 * hstepA, tstepB = 2 * hstepB;
    const unsigned ldsw = (unsigned)wid * 1024u;
    const int aoff = lds_byte(wr * 64 + fr, fq * 8), boff = lds_byte(wc * 32 + fr, fq * 8);
#define PG8_SA(b, h) (((b) * 2 + (h)) * HTB)
#define PG8_SB(b, h) ((4 + (b) * 2 + (h)) * HTB)
#define PG8_STAGE(bufoff, gbase, voff) do { _Pragma("unroll") for (int _i = 0; _i < 2; ++_i) \
        __builtin_amdgcn_global_load_lds((const unsigned*)((const char*)(gbase) + (voff)[_i]), (LAS unsigned*)(lds + (bufoff) + ldsw + _i * 8192), 16, 0, 0); } while (0)
#define PG8_LDA(dst, b, h) do { _Pragma("unroll") for (int m = 0; m < 4; ++m) frag_load<F8>(dst[m], lds + PG8_SA(b, h) + aoff + m * 2048); } while (0)
#define PG8_LDB(dst, b, h) do { _Pragma("unroll") for (int n = 0; n < 2; ++n) frag_load<F8>(dst[n], lds + PG8_SB(b, h) + boff + n * 2048); } while (0)
#define PG8_MMA(ai, bj, At, Bt) do { __builtin_amdgcn_s_setprio(1); _Pragma("unroll") for (int m = 0; m < 4; ++m) _Pragma("unroll") for (int n = 0; n < 2; ++n) \
        acc[ai][bj][m][n] = mma_pair<F8>(Bt[n], At[m], acc[ai][bj][m][n]); __builtin_amdgcn_s_setprio(0); } while (0)
#define PG8_WAIT_V(n) asm volatile("s_waitcnt vmcnt(" #n ")" ::: "memory")
#define PG8_WAIT_L(n) asm volatile("s_waitcnt lgkmcnt(" #n ")" ::: "memory")
#define PG8_BAR __builtin_amdgcn_s_barrier()
#define PG8_SCHED __builtin_amdgcn_sched_barrier(0)
    Unit cur, nxt; int ui = 0;
    if (!S.next(0, cur)) return;
    f32x4 acc[2][2][4][2];
#pragma unroll
    for (int a = 0; a < 2; ++a)
#pragma unroll
        for (int b = 0; b < 2; ++b)
#pragma unroll
            for (int m = 0; m < 4; ++m)
#pragma unroll
                for (int n = 0; n < 2; ++n) acc[a][b][m][n] = (f32x4){0.f, 0.f, 0.f, 0.f};
    Frag<F8> At[4], B0[2], B1[2];
    const char* cA = (const char*)g.A + (size_t)cur.pa * tstepA + (size_t)cur.k0 * kstep; const char* cB = (const char*)g.Bt + (size_t)cur.pb * tstepB + (size_t)cur.k0 * kstep;
    if constexpr (SP2) {
        PG8_STAGE(PG8_SB(0, 0), cB, voffB); PG8_STAGE(PG8_SB(0, 1), cB + hstepB, voffB); PG8_STAGE(PG8_SA(0, 0), cA, voffA); PG8_STAGE(PG8_SA(0, 1), cA + hstepA, voffA);
        if (wr == 1) PG8_BAR;
        PG8_WAIT_V(2); PG8_BAR;
        PG8_STAGE(PG8_SB(1, 0), cB + kstep, voffB); PG8_STAGE(PG8_SA(1, 0), cA + kstep, voffA); PG8_STAGE(PG8_SB(1, 1), cB + hstepB + kstep, voffB);
        PG8_WAIT_V(6); PG8_BAR;
    } else {
        PG8_STAGE(PG8_SB(0, 0), cB, voffB); PG8_STAGE(PG8_SA(0, 0), cA, voffA); PG8_STAGE(PG8_SB(0, 1), cB + hstepB, voffB); PG8_STAGE(PG8_SA(0, 1), cA + hstepA, voffA);
        if (wr == 1) PG8_BAR;
        PG8_WAIT_V(4); PG8_BAR;
        PG8_STAGE(PG8_SB(1, 0), cB + kstep, voffB); PG8_STAGE(PG8_SA(1, 0), cA + kstep, voffA); PG8_STAGE(PG8_SB(1, 1), cB + hstepB + kstep, voffB);
        PG8_WAIT_V(6); PG8_BAR;
    }
    for (;;) {
        const bool has_next = S.next(ui + 1, nxt);
        const char* nA = has_next ? (const char*)g.A + (size_t)nxt.pa * tstepA + (size_t)nxt.k0 * kstep : cA; const char* nB = has_next ? (const char*)g.Bt + (size_t)nxt.pb * tstepB + (size_t)nxt.k0 * kstep : cB;
        const int nt = cur.nkt ? cur.nkt : ntall;
        for (int t = 0; t < nt; t += 2) {
            const bool last = (t == nt - 2);
            const char* a1 = cA + (size_t)(t + 1) * kstep;
            const char* a2 = last ? nA : cA + (size_t)(t + 2) * kstep; const char* b2 = last ? nB : cB + (size_t)(t + 2) * kstep;
            const char* a3 = a2 + kstep; const char* b3 = b2 + kstep;
            if constexpr (SP2) {
            PG8_LDB(B0, 0, 0); PG8_LDB(B1, 0, 1); PG8_SCHED; PG8_LDA(At, 0, 0); PG8_STAGE(PG8_SA(1, 1), a1 + hstepA, voffA);
            PG8_WAIT_V(8); PG8_WAIT_L(0); PG8_BAR; PG8_MMA(0, 0, At, B0); PG8_MMA(0, 1, At, B1); PG8_BAR; PG8_SCHED;
            PG8_LDA(At, 0, 1); PG8_STAGE(PG8_SB(0, 0), b2, voffB); PG8_STAGE(PG8_SB(0, 1), b2 + hstepB, voffB); PG8_STAGE(PG8_SA(0, 0), a2, voffA);
            PG8_WAIT_V(8); PG8_WAIT_L(0); PG8_BAR; PG8_MMA(1, 0, At, B0); PG8_MMA(1, 1, At, B1); PG8_BAR; PG8_SCHED;
            PG8_LDB(B0, 1, 0); PG8_LDB(B1, 1, 1); PG8_SCHED; PG8_LDA(At, 1, 0); PG8_STAGE(PG8_SA(0, 1), a2 + hstepA, voffA);
            PG8_WAIT_V(8); PG8_WAIT_L(0); PG8_BAR; PG8_MMA(0, 0, At, B0); PG8_MMA(0, 1, At, B1); PG8_BAR; PG8_SCHED;
            PG8_LDA(At, 1, 1); PG8_STAGE(PG8_SB(1, 0), b3, voffB); PG8_STAGE(PG8_SB(1, 1), b3 + hstepB, voffB); PG8_STAGE(PG8_SA(1, 0), a3, voffA);
            PG8_WAIT_V(8); PG8_WAIT_L(0); PG8_BAR; PG8_MMA(1, 0, At, B0); PG8_MMA(1, 1, At, B1); PG8_BAR; PG8_SCHED;
            } else {
            PG8_LDB(B0, 0, 0); PG8_SCHED; PG8_LDA(At, 0, 0); PG8_STAGE(PG8_SA(1, 1), a1 + hstepA, voffA);
            PG8_WAIT_L(8); PG8_BAR; PG8_WAIT_L(0); PG8_MMA(0, 0, At, B0); PG8_BAR; PG8_SCHED;
            PG8_LDB(B1, 0, 1); PG8_STAGE(PG8_SB(0, 0), b2, voffB);
            PG8_BAR; PG8_WAIT_L(0); PG8_MMA(0, 1, At, B1); PG8_BAR;
            PG8_LDA(At, 0, 1); PG8_STAGE(PG8_SA(0, 0), a2, voffA);
            PG8_BAR; PG8_WAIT_L(0); PG8_MMA(1, 0, At, B0); PG8_BAR; PG8_SCHED;
            PG8_STAGE(PG8_SB(0, 1), b2 + hstepB, voffB);
            PG8_WAIT_V(6); PG8_BAR; PG8_MMA(1, 1, At, B1); PG8_BAR;
            PG8_LDB(B0, 1, 0); PG8_SCHED; PG8_LDA(At, 1, 0); PG8_STAGE(PG8_SA(0, 1), a2 + hstepA, voffA);
            PG8_WAIT_L(8); PG8_BAR; PG8_WAIT_L(0); PG8_MMA(0, 0, At, B0); PG8_BAR; PG8_SCHED;
            PG8_LDB(B1, 1, 1); PG8_STAGE(PG8_SB(1, 0), b3, voffB);
            PG8_BAR; PG8_WAIT_L(0); PG8_MMA(0, 1, At, B1); PG8_BAR;
            PG8_LDA(At, 1, 1); PG8_STAGE(PG8_SA(1, 0), a3, voffA);
            PG8_BAR; PG8_WAIT_L(0); PG8_MMA(1, 0, At, B0); PG8_BAR; PG8_SCHED;
            PG8_STAGE(PG8_SB(1, 1), b3 + hstepB, voffB);
            PG8_WAIT_V(6); PG8_BAR; PG8_MMA(1, 1, At, B1); PG8_BAR;
            }
        }
        if constexpr (ALIGN_EPI) { if (wr == 0) PG8_BAR; }
        { int fr2 = fr, fq2 = fq; asm volatile("" : "+v"(fr2), "+v"(fq2)); E(acc, cur, wr, wc, fr2, fq2); }
        if (!has_next) break;
#pragma unroll
        for (int a = 0; a < 2; ++a)
#pragma unroll
            for (int b = 0; b < 2; ++b)
#pragma unroll
                for (int m = 0; m < 4; ++m)
#pragma unroll
                    for (int n = 0; n < 2; ++n) acc[a][b][m][n] = (f32x4){0.f, 0.f, 0.f, 0.f};
        cur = nxt; cA = nA; cB = nB; ++ui;
        if constexpr (ALIGN_EPI) { if (wr == 1) PG8_BAR; }
    }
    PG8_WAIT_V(0);
    if constexpr (!ALIGN_EPI) { if (wr == 0) PG8_BAR; }
    PG8_BAR;
#undef PG8_SA
#undef PG8_SB
#undef PG8_STAGE
#undef PG8_LDA
#undef PG8_LDB
#undef PG8_MMA
#undef PG8_WAIT_V
#undef PG8_WAIT_L
#undef PG8_BAR
#undef PG8_SCHED
}
}

#define XB_TMO      128
#define XB_XCNT(j)  (256  + 64 * (j))
#define XB_XSUB(j)  (1280 + 64 * (j))
#define XB_XGEN(j)  (2304 + 64 * (j))
#define XB_TOP      3328
#define XB_TOPGEN   3392
#define XCD_BAR_WORDS 3456
#define XB_SPIN_CAP (1u << 20)
__device__ __forceinline__ unsigned xb_ld(unsigned* p)              { return __hip_atomic_load(p, __ATOMIC_RELAXED, __HIP_MEMORY_SCOPE_AGENT); }
__device__ __forceinline__ unsigned xb_add(unsigned* p, unsigned v) { return __hip_atomic_fetch_add(p, v, __ATOMIC_RELAXED, __HIP_MEMORY_SCOPE_AGENT); }
__device__ __forceinline__ unsigned xb_xcc_id() { return (unsigned)__builtin_amdgcn_s_getreg((3 << 11) | 20) & 0xFu; }
#define XB_SPIN(cond, bar) do { unsigned _sp = 0; while (cond) { __builtin_amdgcn_s_sleep(1); \
    if ((++_sp & 255u) == 0u) { if (xb_ld(&(bar)[XB_TMO])) break; if (_sp > XB_SPIN_CAP) { atomicAdd(&(bar)[XB_TMO], 1u); break; } } } } while (0)
struct XcdBarrier { unsigned* bar; unsigned x; volatile LAS unsigned* st; };
__device__ __forceinline__ XcdBarrier xcd_barrier_post(unsigned* bar, volatile LAS unsigned* st) {
    XcdBarrier b; b.bar = bar; b.x = xb_xcc_id(); b.st = st;
    if (threadIdx.x == 0) (void)xb_add(&bar[XB_XCNT(b.x)], 1u);
    return b;
}
__device__ __forceinline__ void xcd_barrier_complete(unsigned* bar, unsigned x, unsigned& nloc, unsigned& nx) {
    const unsigned G = gridDim.x * gridDim.y * gridDim.z;
    unsigned sum, cnt, mine, sp = 0u;
    for (;;) {
        sum = 0u; cnt = 0u; mine = 0u;
#pragma unroll
        for (unsigned j = 0; j < 16; ++j) { const unsigned c = xb_ld(&bar[XB_XCNT(j)]); sum += c; cnt += (c > 0u) ? 1u : 0u; mine = (j == x) ? c : mine; }
        if (sum == G) break;
        __builtin_amdgcn_s_sleep(1);
        if ((++sp & 255u) == 0u) { if (xb_ld(&bar[XB_TMO])) break; if (sp > XB_SPIN_CAP) { atomicAdd(&bar[XB_TMO], 1u); break; } }
    }
    nloc = mine > 0u ? mine : 1u; nx = cnt > 0u ? cnt : 1u;
}
__device__ __forceinline__ void xcd_barrier(const XcdBarrier& b) {
    asm volatile("s_waitcnt vmcnt(0)" ::: "memory");
    __syncthreads();
    if (threadIdx.x == 0) {
        unsigned* bar = b.bar;
        __builtin_amdgcn_s_waitcnt(0);
        unsigned nloc = b.st[0], nx = b.st[1];
        if (nloc == 0u) { xcd_barrier_complete(bar, b.x, nloc, nx); b.st[0] = nloc; b.st[1] = nx; }
        const unsigned old = xb_add(&bar[XB_XSUB(b.x)], 1u);
        const unsigned gen = old / nloc;
        if (old + 1u == (gen + 1u) * nloc) {
            __builtin_amdgcn_fence(__ATOMIC_RELEASE, "agent");
            asm volatile("s_waitcnt vmcnt(0)" ::: "memory");
            const unsigned og = xb_add(&bar[XB_TOP], 1u);
            const unsigned tg = og / nx;
            if (og + 1u == (tg + 1u) * nx) xb_add(&bar[XB_TOPGEN], 1u);
            else XB_SPIN(xb_ld(&bar[XB_TOPGEN]) == tg, bar);
            __builtin_amdgcn_fence(__ATOMIC_ACQUIRE, "agent");
            xb_add(&bar[XB_XGEN(b.x)], 1u);
            asm volatile("s_waitcnt vmcnt(0)" ::: "memory");
        } else {
            XB_SPIN(xb_ld(&bar[XB_XGEN(b.x)]) == gen, bar);
            __builtin_amdgcn_fence(__ATOMIC_ACQUIRE, "agent");
            asm volatile("s_waitcnt vmcnt(0)" ::: "memory");
        }
    }
    __syncthreads();
}

constexpr int DM = 1024, NBATCH = 4, SEQL = 8192, CTXL = 256;
constexpr int TL = NBATCH * SEQL, TCX = NBATCH * CTXL, TT = TL + TCX;
constexpr int NCHK = TT / 64;
constexpr int NRT = TT / 256;
constexpr int INC = 6688, NINP = 6912, PMC = 2560, SGC = 4096;
constexpr int DFF = 2816, DEX = 3584, NEX = 8;
constexpr int MOE_ROWS = 34816;
constexpr float EPS = 1e-6f;
constexpr int NTHR = 512, NWAVE = 8;
constexpr int LDS_BYTES = 147456;
constexpr int LDS_MISC = 144384;

constexpr size_t al4k(size_t x) { return (x + 4095) & ~(size_t)4095; }
constexpr size_t O_CTL = 0,                          SZ_CTL = 1u << 20;
constexpr size_t O_MODS = O_CTL + SZ_CTL,            SZ_MODS = al4k((size_t)2 * 5 * 6144 * 4);
constexpr size_t O_TW = O_MODS + SZ_MODS,            SZ_TW = 8192 * 8 + (size_t)192 * 512 * 4;
constexpr size_t O_PE = O_TW + 8192 * 8;
constexpr size_t O_HFIL = O_TW + SZ_TW,              SZ_HFIL = (size_t)2 * 512 * 8192 * 4;
constexpr size_t O_HPS = O_HFIL + SZ_HFIL,           SZ_HPS = (size_t)2 * 512 * 128 * 4;
constexpr size_t O_HFILC = O_HPS + SZ_HPS,           SZ_HFILC = (size_t)512 * 256 * 4;
constexpr size_t O_HPSC = O_HFILC + SZ_HFILC,        SZ_HPSC = al4k(512 * 4 * 4);
constexpr size_t O_XCTX = O_HPSC + SZ_HPSC,          SZ_XCTX = (size_t)TCX * DM * 4;
constexpr size_t O_TOKI = O_XCTX + SZ_XCTX,          SZ_TOKI = (size_t)TL * 16 + (size_t)TL * 8;
constexpr size_t O_TPOS = O_TOKI + (size_t)TL * 16;
constexpr size_t O_RTOK = O_TOKI + SZ_TOKI,          SZ_RTOK = al4k((size_t)2 * MOE_ROWS * 4);
constexpr size_t O_RW = O_RTOK + SZ_RTOK,            SZ_RW = al4k((size_t)2 * MOE_ROWS * 4);
constexpr size_t O_GDEC = O_RW + SZ_RW,              SZ_GDEC = al4k((size_t)8 * NCHK * 64 * 4);
constexpr size_t O_RGP = O_GDEC + SZ_GDEC,           SZ_RGP = al4k((size_t)2 * NCHK * 256 * 4);
constexpr size_t O_RGH = O_RGP + SZ_RGP,             SZ_RGH = SZ_RGP;
constexpr size_t O_S5PW = O_RGH + SZ_RGH,           SZ_S5PW = al4k((size_t)2 * 16 * 2 * 65 * 64 * 8);
constexpr size_t O_S5Q = O_S5PW + SZ_S5PW,           SZ_S5Q = al4k((size_t)2 * 16 * 2 * 64 * 8);
constexpr size_t O_S5K = O_S5Q + SZ_S5Q,             SZ_S5K = (size_t)2 * 16 * 2 * 64 * 256 * 4;
constexpr size_t O_WRG = O_S5K + SZ_S5K,             SZ_WRG = (size_t)2 * 1024 * 256 * 2;
constexpr size_t O_RGSP = O_WRG + SZ_WRG,            SZ_RGSP = al4k(2 * 2 * 256 * 4);
constexpr size_t O_WIN = O_RGSP + SZ_RGSP,             SZ_WIN = (size_t)2 * NINP * DM * 2;
constexpr size_t O_WBR = O_WIN + SZ_WIN,             SZ_WBR = (size_t)2 * 4 * 1024 * 256 * 2;
constexpr size_t O_WOUT = O_WBR + SZ_WBR,            SZ_WOUT = (size_t)2 * 1024 * 1024 * 2;
constexpr size_t O_WGU = O_WOUT + SZ_WOUT,           SZ_WGU = (size_t)2 * DFF * DM * 2;
constexpr size_t O_WDN = O_WGU + SZ_WGU,             SZ_WDN = (size_t)DM * DFF * 2;
constexpr size_t O_WGLU = O_WDN + SZ_WDN,            SZ_WGLU = (size_t)2 * 256 * 256 * 2;
constexpr size_t O_H = O_WGLU + SZ_WGLU,             SZ_H = (size_t)TT * DM * 2;
constexpr size_t O_PM = O_H + SZ_H,                  SZ_PM = (size_t)TT * PMC * 2;
constexpr size_t O_SG = O_PM + SZ_PM,                SZ_SG = (size_t)TT * SGC * 2;
constexpr size_t O_GDN = O_SG + SZ_SG,               SZ_GDN = al4k((size_t)TT * 32 * 2);
constexpr size_t O_BR = O_GDN + SZ_GDN,              SZ_BR = (size_t)4 * TT * 256 * 2;
constexpr size_t O_UH = O_BR + SZ_BR,                SZ_UH = (size_t)16 * 768 * 1280 * 2;
constexpr size_t O_TCM = O_UH + SZ_UH,               SZ_TCM = (size_t)16 * 1024 * 1280 * 2;
constexpr size_t O_BPOW = O_TCM + SZ_TCM,            SZ_BPOW = (size_t)16 * 256 * 1024 * 2;
constexpr size_t O_HC = O_BPOW + SZ_BPOW,            SZ_HC = (size_t)16 * 768 * 256 * 4;
constexpr size_t O_GBUF = O_HC + SZ_HC,              SZ_GBUF = (size_t)TT * 256 * 2;
constexpr size_t O_ZT = O_GBUF + SZ_GBUF,            SZ_ZT = (size_t)4 * 256 * 8192 * 4;
constexpr size_t O_ZC = O_ZT + SZ_ZT,                SZ_ZC = (size_t)4 * 256 * 256 * 4;
constexpr size_t O_CZC = O_ZC + SZ_ZC,               SZ_CZC = SZ_ZC;
constexpr size_t O_GS = O_BR,                        SZ_GS = 0;
constexpr size_t O_GS16 = O_SG + (size_t)TT * SGC;
constexpr size_t O_XC = O_BR + (size_t)3 * TT * 256 * 2;
constexpr size_t O_ENDZ = O_CZC + SZ_CZC;
constexpr size_t O_RLA = O_ENDZ,                      SZ_RLA = (size_t)2 * TT * 256 * 2;
constexpr size_t O_RBT = O_RLA + SZ_RLA,             SZ_RBT = SZ_RLA;
constexpr size_t WS_END = O_RBT + SZ_RBT;
constexpr size_t O_CZT = O_ZT;
constexpr size_t O_YMF = O_PM;
constexpr size_t O_FMID = O_PM;
constexpr size_t O_XB = O_SG + (size_t)TT * SGC + (size_t)8 * NCHK * 4096 * 2, SZ_XB = (size_t)TT * DM * 2;
constexpr size_t O_MWGU = O_PM,                      SZ_MWGU = (size_t)NEX * 2 * DEX * DM;
constexpr size_t O_MWDN = O_MWGU + SZ_MWGU,          SZ_MWDN = (size_t)NEX * DM * DEX;
constexpr size_t O_H2S = O_MWDN + SZ_MWDN,           SZ_H2S = (size_t)2 * MOE_ROWS * DM * 2;
constexpr size_t O_MMID = O_XB + SZ_XB,              SZ_MMID = (size_t)MOE_ROWS * DEX * 2;
static_assert((size_t)TT * DFF <= O_XB - O_PM && O_H2S + SZ_H2S <= O_XB && O_XB + SZ_XB <= O_SG + SZ_SG && O_MMID + SZ_MMID <= WS_END, "overlays");
static_assert((size_t)8 * NCHK * 4096 * 4 <= SZ_H && (size_t)TT * SGC + (size_t)8 * NCHK * 4096 * 2 <= SZ_SG, "GLA states fit the h buffer / the spare half of the gate buffer");
constexpr int CW_BAR = 4096, CW_CNT = 8192, CW_BLK = 16384;

struct Args { const float* in[44]; float* out; unsigned char* ws; int ph_lo, ph_hi; };
typedef const __attribute__((address_space(4))) Args CArgs;
__device__ __forceinline__ CArgs* kargs() { CArgs* p = (CArgs*)__builtin_amdgcn_kernarg_segment_ptr(); asm volatile("" : "+s"(p)); return p; }
#define KA (*kargs())
enum { I_X = 0, I_C, I_CTX, I_CCTX, I_MODW, I_MODB, I_N1G, I_N2G, I_WIN, I_GWUP, I_GBUP, I_LRE, I_LIM, I_LDT, I_BRE, I_BIM, I_CRE, I_CIM, I_S5D, I_WGLU, I_BGLU,
       I_HWS, I_HW1, I_HB1, I_HW2, I_HB2, I_HW3, I_HFR, I_HBIAS, I_RWC, I_RWA, I_RBA, I_RWX, I_RBX, I_RLAM, I_WBR, I_WOUT, I_FGU, I_FDN, I_MRT, I_MRB, I_MGU, I_MDN, I_FING };

#define WSP(T, off) ((T*)(A.ws + (off)))

__device__ __forceinline__ int seq_chunk(int b, int d, int step) {
    if (step < 4) return 512 + 4 * b + (d ? 3 - step : step);
    const int c = step - 4; return 128 * b + (d ? 127 - c : c);
}
__device__ __forceinline__ void seq_bounds(int n, int& s0, int& s1) {
    if (n < 512) { s0 = (n >> 7) * SEQL; s1 = s0 + SEQL; } else { s0 = TL + ((n - 512) >> 2) * CTXL; s1 = s0 + CTXL; }
}

__device__ __forceinline__ void transpose_item(const float* W, int N, int k0, int n0, bf16* WT, int drow0, int ldk, LAS float* scr, int lane) {
    const float* src = W + (size_t)(k0 + (lane >> 3)) * N + n0 + 4 * (lane & 7);
    f32x4 v[16];
#pragma unroll
    for (int i = 0; i < 16; ++i) v[i] = __builtin_nontemporal_load((const f32x4*)(src + (size_t)(8 * i) * N));
#pragma unroll
    for (int i = 0; i < 16; ++i) { LAS float* d = scr + (8 * i + (lane >> 3)) * 33 + 4 * (lane & 7); d[0] = v[i][0]; d[1] = v[i][1]; d[2] = v[i][2]; d[3] = v[i][3]; }
    asm volatile("s_waitcnt lgkmcnt(0)" ::: "memory");
    const int kg = lane & 15;
#pragma unroll
    for (int q = 0; q < 8; ++q) { const int n = (lane >> 4) + 4 * q; const LAS float* s = scr + (8 * kg) * 33 + n;
        u32x4 o; o.x = pk2(s[0], s[33]); o.y = pk2(s[66], s[99]); o.z = pk2(s[132], s[165]); o.w = pk2(s[198], s[231]);
        *(u32x4*)(WT + (size_t)(drow0 + n) * ldk + k0 + 8 * kg) = o; }
    asm volatile("s_waitcnt lgkmcnt(0)" ::: "memory");
}
__device__ __forceinline__ void transpose_item8(const float* W, int N, int k0, int n0, unsigned char* WT, int drow0, int ldk, LAS float* scr, int lane) {
    const float* src = W + (size_t)(k0 + (lane >> 3)) * N + n0 + 4 * (lane & 7);
    f32x4 v[16];
#pragma unroll
    for (int i = 0; i < 16; ++i) v[i] = __builtin_nontemporal_load((const f32x4*)(src + (size_t)(8 * i) * N));
#pragma unroll
    for (int i = 0; i < 16; ++i) { LAS float* d = scr + (8 * i + (lane >> 3)) * 33 + 4 * (lane & 7); d[0] = v[i][0]; d[1] = v[i][1]; d[2] = v[i][2]; d[3] = v[i][3]; }
    asm volatile("s_waitcnt lgkmcnt(0)" ::: "memory");
    const int kg = lane & 7;
#pragma unroll
    for (int q = 0; q < 4; ++q) { const int n = (lane >> 3) + 8 * q; const LAS float* s = scr + (16 * kg) * 33 + n;
        u32x4 o; o.x = pack4_fp8(32.f * s[0], 32.f * s[33], 32.f * s[66], 32.f * s[99]); o.y = pack4_fp8(32.f * s[132], 32.f * s[165], 32.f * s[198], 32.f * s[231]);
        o.z = pack4_fp8(32.f * s[264], 32.f * s[297], 32.f * s[330], 32.f * s[363]); o.w = pack4_fp8(32.f * s[396], 32.f * s[429], 32.f * s[462], 32.f * s[495]);
        *(u32x4*)(WT + (size_t)(drow0 + n) * ldk + k0 + 16 * kg) = o; }
    asm volatile("s_waitcnt lgkmcnt(0)" ::: "memory");
}
__device__ __forceinline__ void transpose_item8_64(const float* W, int N, int k0, int n0, unsigned char* WT, int drow0, int ldk, LAS float* scr, int lane) {
    const float* src = W + (size_t)(k0 + (lane >> 4)) * N + n0 + 4 * (lane & 15);
    f32x4 v[16];
#pragma unroll
    for (int i = 0; i < 16; ++i) v[i] = __builtin_nontemporal_load((const f32x4*)(src + (size_t)(4 * i) * N));
#pragma unroll
    for (int i = 0; i < 16; ++i) { LAS float* d = scr + (4 * i + (lane >> 4)) * 65 + 4 * (lane & 15); d[0] = v[i][0]; d[1] = v[i][1]; d[2] = v[i][2]; d[3] = v[i][3]; }
    asm volatile("s_waitcnt lgkmcnt(0)" ::: "memory");
    const int kg = lane & 3;
#pragma unroll
    for (int q = 0; q < 4; ++q) { const int n = (lane >> 2) + 16 * q; const LAS float* s = scr + (16 * kg) * 65 + n;
        u32x4 o; o.x = pack4_fp8(32.f * s[0], 32.f * s[65], 32.f * s[130], 32.f * s[195]); o.y = pack4_fp8(32.f * s[260], 32.f * s[325], 32.f * s[390], 32.f * s[455]);
        o.z = pack4_fp8(32.f * s[520], 32.f * s[585], 32.f * s[650], 32.f * s[715]); o.w = pack4_fp8(32.f * s[780], 32.f * s[845], 32.f * s[910], 32.f * s[975]);
        *(u32x4*)(WT + (size_t)(drow0 + n) * ldk + k0 + 16 * kg) = o; }
    asm volatile("s_waitcnt lgkmcnt(0)" ::: "memory");
}
__device__ __forceinline__ int inproj_dest(int n0) {
    if (n0 < 1024) return n0;
    if (n0 < 1056) return 6656 + (n0 - 1024);
    if (n0 < 1312) return 1024 + (n0 - 1056);
    if (n0 < 2080) return 1280 + (n0 - 1312);
    if (n0 < 2592) return 2048 + (n0 - 2080);
    return 2560 + (n0 - 2592);
}
__device__ __forceinline__ int swiglu_dest(int n0, int dh) { return n0 < dh ? (n0 / 128) * 256 + (n0 % 128) : ((n0 - dh) / 128) * 256 + 128 + ((n0 - dh) % 128); }

#ifndef PRO_DUP
#define PRO_DUP 0
#endif
__device__ __forceinline__ void s5_tables(CArgs& A);
__device__ __forceinline__ void s5_ktable_unit(CArgs& A, LAS unsigned char* lds, int u);
__device__ __forceinline__ void ph_prologue(CArgs& A, LAS unsigned char* lds) {
    const int tid = tidx(), lane = tid & 63, wave = tid >> 6, G = gdim();
    const int gw = bidx() * NWAVE + wave, NGW = G * NWAVE;
    for (int rp = 0; rp < (PRO_DUP == 1 ? 2 : 1); ++rp) for (int u = bidx(); u < 256; u += G) s5_ktable_unit(A, lds, u);
    s5_tables(A);
    LAS float* scr = (LAS float*)(lds + wave * 17408);
    constexpr int I_IN = 2 * 8 * 209, I_BR = 8 * 64, I_OUT = 2 * 256, I_GU = 8 * 176, I_DN = 22 * 32, I_GL = 2 * 16;
    constexpr int NIT = I_IN + I_BR + I_OUT + I_GU + I_DN + I_GL;
    for (int rp = 0; rp < (PRO_DUP == 2 ? 2 : 1); ++rp) for (int it = gw; it < NIT; it += NGW) {
        int r = it;
        if (r < I_IN) { const int l = r / 1672, r2 = r % 1672, kb = r2 / 209, nb = r2 % 209;
            transpose_item(A.in[I_WIN] + (size_t)l * DM * INC, INC, kb * 128, nb * 32, WSP(bf16, O_WIN) + (size_t)l * NINP * DM, inproj_dest(nb * 32), DM, scr, lane); continue; } r -= I_IN;
        if (r < I_BR) { const int m = r / 64, r2 = r % 64, kb = r2 / 32, nb = r2 % 32;
            transpose_item(A.in[I_WBR] + (size_t)m * 256 * 1024, 1024, kb * 128, nb * 32, WSP(bf16, O_WBR) + (size_t)m * 1024 * 256, nb * 32, 256, scr, lane); continue; } r -= I_BR;
        if (r < I_OUT) { const int l = r / 256, r2 = r % 256, kb = r2 / 32, nb = r2 % 32;
            transpose_item(A.in[I_WOUT] + (size_t)l * 1024 * 1024, 1024, kb * 128, nb * 32, WSP(bf16, O_WOUT) + (size_t)l * 1024 * 1024, nb * 32, 1024, scr, lane); continue; } r -= I_OUT;
        if (r < I_GU) { const int kb = r / 176, nb = r % 176;
            transpose_item8(A.in[I_FGU], 2 * DFF, kb * 128, nb * 32, WSP(unsigned char, O_WGU), swiglu_dest(nb * 32, DFF), DM, scr, lane); continue; } r -= I_GU;
        if (r < I_DN) { const int kb = r / 32, nb = r % 32;
            transpose_item8(A.in[I_FDN], DM, kb * 128, nb * 32, WSP(unsigned char, O_WDN), nb * 32, DFF, scr, lane); continue; } r -= I_DN;
        { const int l = r / 16, r2 = r % 16, kb = r2 / 8, nb = r2 % 8;
            transpose_item(A.in[I_WGLU] + (size_t)l * 65536, 256, kb * 128, nb * 32, WSP(bf16, O_WGLU) + (size_t)l * 65536, nb * 32, 256, scr, lane); }
    }
    const int gt = bidx() * NTHR + tid, NT = G * NTHR;
    for (int i = gt; i < 2 * 224 * 128; i += NT) { const int l = i / (224 * 128), r2 = i % (224 * 128);
        *(u32x4*)(WSP(bf16, O_WIN) + ((size_t)l * NINP + INC) * DM + (size_t)r2 * 8) = (u32x4){0u, 0u, 0u, 0u}; }
    for (int i = gt; i < 8192; i += NT) { float s, c; sincospif(-(float)i * (1.0f / 8192.0f), &s, &c); WSP(f32x2, O_TW)[i] = (f32x2){c, s}; }
    for (int i = gt; i < 192 * 256; i += NT) { const int p = i >> 8, k = i & 255; const float om = expf(-(float)k * (9.210340371976184f / 256.0f)); const float a = (float)(p < 128 ? p : p - 128) * om; float sn, cs; sincosf(a, &sn, &cs);
        WSP(float, O_PE)[p * 512 + k] = sn; WSP(float, O_PE)[p * 512 + 256 + k] = cs; }
    for (int i = gt; i < 2 * 1024 * 256; i += NT) { const int l = i >> 18, row = (i >> 8) & 1023, k = i & 255, tile = row >> 8, d = tile >> 1, hf = tile & 1, which = (row >> 7) & 1, ch = hf * 128 + (row & 127), blk = ch >> 6;
        const float* w = A.in[which ? I_RWX : I_RWA]; const float v = ((k >> 6) == blk) ? w[((size_t)(((l * 2 + d) * 4 + blk) * 64 + (k & 63))) * 64 + (ch & 63)] : 0.f;
        WSP(bf16, O_WRG)[i] = (bf16)f2bf(v); }
    for (int i = gt; i < 2 * 2 * 256; i += NT) WSP(float, O_RGSP)[i] = log1pf(expf(-A.in[I_RLAM][i]));
    __syncthreads();
    {
        LAS float* sSilu = (LAS float*)lds; LAS float* sRed = (LAS float*)(lds + 20480);
        for (int rp = 0; rp < (PRO_DUP == 3 ? 2 : 1); ++rp) for (int u = (G == 256 ? bidx() - 64 : bidx()); u < 192; u += G) {
            if (u < 0) continue;
            const int l = u / 96, cb = u % 96;
            for (int i = tid; i < 5120; i += NTHR) { const int cnd = i >> 10, k = i & 1023; const float v = cnd < 4 ? A.in[I_C][cnd * 1024 + k] : A.in[I_CCTX][k]; sSilu[i] = silu_acc(v); }
            __syncthreads();
            float acc[5] = {0.f, 0.f, 0.f, 0.f, 0.f};
            const float* wp = A.in[I_MODW] + (size_t)l * DM * 6144 + cb * 64 + lane;
            for (int k0 = wave * 128; k0 < wave * 128 + 128; k0 += 32) { float wv[32];
#pragma unroll
                for (int q = 0; q < 32; ++q) wv[q] = wp[(size_t)(k0 + q) * 6144];
#pragma unroll
                for (int q = 0; q < 32; ++q)
#pragma unroll
                    for (int c = 0; c < 5; ++c) acc[c] += sSilu[c * 1024 + k0 + q] * wv[q]; }
#pragma unroll
            for (int c = 0; c < 5; ++c) sRed[(wave * 5 + c) * 64 + lane] = acc[c];
            __syncthreads();
            if (tid < 320) { const int c = tid >> 6, ln = tid & 63; float s = A.in[I_MODB][l * 6144 + cb * 64 + ln];
#pragma unroll
                for (int w = 0; w < 8; ++w) s += sRed[(w * 5 + c) * 64 + ln];
                WSP(float, O_MODS)[(l * 5 + c) * 6144 + cb * 64 + ln] = s; }
            __syncthreads();
        }
    }
    {
        LAS float* zf = (LAS float*)lds; LAS float* h1 = (LAS float*)(lds + 8448); LAS float* h2 = (LAS float*)(lds + 8448 + 16384);
        for (int rp = 0; rp < (PRO_DUP == 4 ? 2 : 1); ++rp) for (int u = bidx(); u < 260; u += G) {
            const int l = u < 256 ? u / 128 : 0, tb = u < 256 ? u % 128 : u - 256, ntok = u < 256 ? 8192 : 256, nps = u < 256 ? 128 : 4;
            float* outp = u < 256 ? WSP(float, O_HFIL) + (size_t)l * 512 * 8192 : WSP(float, O_HFILC);
            float* psp = u < 256 ? WSP(float, O_HPS) + (size_t)l * 512 * 128 : WSP(float, O_HPSC);
            const int t0 = tb * 64;
            for (int idx = tid; idx < 64 * 33; idx += NTHR) { const int pos = idx / 33, f = idx % 33; const double t = (double)(t0 + pos); float v;
                if (f == 0) v = (float)(t / ntok);
                else { const int kk = (f - 1) & 15; const double band = 1e-4 + kk * ((15.0 - 1e-4) / 15.0); const double angp = 2.0 * band * t / ntok; v = f <= 16 ? (float)cospi(angp) : (float)sinpi(angp); }
                zf[idx] = v; }
            __syncthreads();
            { const int j = tid & 63, pg = tid >> 6; const float fr = A.in[I_HFR][l * 64 + j], bb = A.in[I_HB1][l * 64 + j];
              float s[8];
#pragma unroll
              for (int i = 0; i < 8; ++i) s[i] = bb;
              float w1r[33];
#pragma unroll
              for (int f = 0; f < 33; ++f) w1r[f] = A.in[I_HW1][(l * 33 + f) * 64 + j];
#pragma unroll
              for (int f = 0; f < 33; ++f) {
#pragma unroll
                  for (int i = 0; i < 8; ++i) s[i] += zf[(pg * 8 + i) * 33 + f] * w1r[f]; }
#pragma unroll
              for (int i = 0; i < 8; ++i) h1[(pg * 8 + i) * 64 + j] = s[i];
#pragma unroll 1
              for (int i = 0; i < 8; ++i) { LAS float* hp_ = h1 + (pg * 8 + i) * 64 + j; *hp_ = sinf(fr * *hp_); } }
            __syncthreads();
            { const int j = tid & 63, pg = tid >> 6; const float fr = A.in[I_HFR][l * 64 + j], bb = A.in[I_HB2][l * 64 + j];
              float s[8];
#pragma unroll
              for (int i = 0; i < 8; ++i) s[i] = bb;
              float w2r[64];
#pragma unroll
              for (int f = 0; f < 64; ++f) w2r[f] = A.in[I_HW2][(l * 64 + f) * 64 + j];
#pragma unroll
              for (int f = 0; f < 64; ++f) {
#pragma unroll
                  for (int i = 0; i < 8; ++i) s[i] += h1[(pg * 8 + i) * 64 + f] * w2r[f]; }
#pragma unroll
              for (int i = 0; i < 8; ++i) h2[(pg * 8 + i) * 65 + j] = s[i];
#pragma unroll 1
              for (int i = 0; i < 8; ++i) { LAS float* hp_ = h2 + (pg * 8 + i) * 65 + j; *hp_ = sinf(fr * *hp_); } }
            __syncthreads();
            {
              const int lane = tid & 63, w = tid >> 6, l31 = lane & 31, kh = lane >> 5;
              const float dlo = -4.605170185988091f / 0.3f, dhi = -4.605170185988091f / 1.5f;
              const float inv = 1.0f / (float)(ntok - 1);
              const float* w3p = A.in[I_HW3] + (size_t)l * 64 * 512 + w * 64 + l31; float bw[2][32];
#pragma unroll
              for (int ks = 0; ks < 32; ++ks) { bw[0][ks] = w3p[(2 * ks + kh) * 512]; bw[1][ks] = w3p[(2 * ks + kh) * 512 + 32]; }
              f32x16 acc[2][2];
#pragma unroll
              for (int i = 0; i < 16; ++i) { acc[0][0][i] = 0.f; acc[0][1][i] = 0.f; acc[1][0][i] = 0.f; acc[1][1][i] = 0.f; }
#pragma unroll
              for (int ks = 0; ks < 32; ++ks) { const float a0 = h2[l31 * 65 + 2 * ks + kh], a1 = h2[(32 + l31) * 65 + 2 * ks + kh];
                  acc[0][0] = __builtin_amdgcn_mfma_f32_32x32x2f32(a0, bw[0][ks], acc[0][0], 0, 0, 0); acc[0][1] = __builtin_amdgcn_mfma_f32_32x32x2f32(a0, bw[1][ks], acc[0][1], 0, 0, 0);
                  acc[1][0] = __builtin_amdgcn_mfma_f32_32x32x2f32(a1, bw[0][ks], acc[1][0], 0, 0, 0); acc[1][1] = __builtin_amdgcn_mfma_f32_32x32x2f32(a1, bw[1][ks], acc[1][1], 0, 0, 0); }
#pragma unroll
              for (int ct = 0; ct < 2; ++ct) { const int c = w * 64 + ct * 32 + l31; const float delta = fabsf(dlo + (float)(c & 255) * ((dhi - dlo) / 255.0f)); float asum = 0.f;
#pragma unroll
                  for (int rt = 0; rt < 2; ++rt)
#pragma unroll
                      for (int i4 = 0; i4 < 4; ++i4) { const int pos = 32 * rt + 8 * i4 + 4 * kh; f32x4 o;
#pragma unroll
                          for (int e = 0; e < 4; ++e) { const float val = acc[rt][ct][4 * i4 + e] * expf(-((float)(t0 + pos + e) * inv) * delta); o[e] = val; asum += fabsf(val); }
                          *(f32x4*)(outp + (size_t)c * ntok + t0 + pos) = o; }
                  asum += __shfl_xor(asum, 32); if (kh == 0) psp[c * nps + tb] = asum; } }
            __syncthreads();
        }
    }
}

__device__ __forceinline__ void ph_norm(CArgs& A, LAS unsigned char* lds, int l, int which, bool first, bool router) {
    const int tid = tidx(), lane = tid & 63, wave = tid >> 6, G = gdim();
    const int gw = bidx() * NWAVE + wave, NGW = G * NWAVE;
    const int nrows = router ? TL : TT;
    LAS unsigned* sCnt = (LAS unsigned*)lds; const int tpb = TL / G;
    if (router) { if (tid < 16) sCnt[tid] = 0u; __syncthreads(); }
    const float* gp = A.in[which ? I_N2G : I_N1G] + l * DM;
    bf16* H = WSP(bf16, O_H);
    const float* xin = A.in[I_X]; const float* cin = A.in[I_CTX]; bf16* XB = WSP(bf16, O_XB);
#define NORM_SRC(r) ((r) < TL ? xin + (size_t)(r) * DM : cin + (size_t)((r) - TL) * DM)
#define NORM_LD(dst, r) do { if (first) { const float* s_ = NORM_SRC(r); _Pragma("unroll") for (int j = 0; j < 4; ++j) dst[j] = ((const f32x4*)s_)[lane + 64 * j]; } \
        else { const u32x2* s_ = (const u32x2*)(XB + (size_t)(r) * DM); _Pragma("unroll") for (int j = 0; j < 4; ++j) { const u32x2 w_ = s_[lane + 64 * j]; dst[j] = (f32x4){bflo(w_.x), bfhi(w_.x), bflo(w_.y), bfhi(w_.y)}; } } } while (0)
#define NORM_ROW(it) (router ? bidx() * tpb + wave + (it) * NWAVE : gw + (it) * NGW)
#define NORM_OK(it, r) (router ? ((it) * NWAVE < tpb) : ((r) < nrows))
    f32x4 vn[4]; f32x4 gsv[4], shv[4]; int ccur = -1;
    f32x4 rtw[16][2];
    if (router) {
#pragma unroll
        for (int j = 0; j < 4; ++j)
#pragma unroll
            for (int q = 0; q < 4; ++q) { const float* rp = A.in[I_MRT] + (size_t)(4 * lane + 256 * j + q) * 8; rtw[j * 4 + q][0] = *(const f32x4*)rp; rtw[j * 4 + q][1] = *(const f32x4*)(rp + 4); } }
    { const int r0 = NORM_ROW(0); if (NORM_OK(0, r0)) NORM_LD(vn, r0); }
    for (int it = 0;; ++it) {
        const int r = NORM_ROW(it);
        if (!NORM_OK(it, r)) break;
        const int cond = r < TL ? (r >> 13) : 4;
        f32x4 v[4];
#pragma unroll
        for (int j = 0; j < 4; ++j) v[j] = vn[j];
        { const int rn = NORM_ROW(it + 1); if (NORM_OK(it + 1, rn)) NORM_LD(vn, rn); }
        if (first) {
            if (r < TL) { const int t = r & (SEQL - 1); const f32x4* pr = (const f32x4*)(WSP(float, O_PE) + (t >> 6) * 512); const f32x4* pc = (const f32x4*)(WSP(float, O_PE) + (128 + (t & 63)) * 512);
                v[0] = v[0] + pr[lane]; v[1] = v[1] + pr[64 + lane]; v[2] = v[2] + pc[lane]; v[3] = v[3] + pc[64 + lane]; }
#pragma unroll
            for (int j = 0; j < 4; ++j) ((u32x2*)(XB + (size_t)r * DM))[lane + 64 * j] = (u32x2){pk2(v[j][0], v[j][1]), pk2(v[j][2], v[j][3])};
        }
        float ss = 0.f;
#pragma unroll
        for (int j = 0; j < 4; ++j) ss += (v[j][0] * v[j][0] + v[j][1] * v[j][1]) + (v[j][2] * v[j][2] + v[j][3] * v[j][3]);
        const float rstd = 1.0f / sqrtf(wave_sum(ss) * (1.0f / DM) + EPS);
        if (cond != ccur) { ccur = cond; const float* mp = WSP(float, O_MODS) + (size_t)(l * 5 + cond) * 6144 + which * 3072;
#pragma unroll
            for (int j = 0; j < 4; ++j) { const f32x4 g = ((const f32x4*)gp)[lane + 64 * j], sh = ((const f32x4*)mp)[lane + 64 * j], sc = ((const f32x4*)(mp + 1024))[lane + 64 * j]; gsv[j] = g * (sc + 1.0f); shv[j] = sh; } }
#pragma unroll
        for (int j = 0; j < 4; ++j) {
            v[j] = v[j] * rstd * gsv[j] + shv[j];
            if (which) ((unsigned*)((unsigned char*)H + (size_t)r * DM))[lane + 64 * j] = pack4_fp8(v[j][0], v[j][1], v[j][2], v[j][3]);
            else ((u32x2*)(H + (size_t)r * DM))[lane + 64 * j] = (u32x2){pk2(v[j][0], v[j][1]), pk2(v[j][2], v[j][3])}; }
        if (router) {
            float lg[8];
#pragma unroll
            for (int e = 0; e < 8; ++e) lg[e] = 0.f;
#pragma unroll
            for (int j = 0; j < 4; ++j)
#pragma unroll
                for (int q = 0; q < 4; ++q) { const f32x4 r0 = rtw[j * 4 + q][0], r1 = rtw[j * 4 + q][1]; const float xv = v[j][q];
                    lg[0] += xv * r0[0]; lg[1] += xv * r0[1]; lg[2] += xv * r0[2]; lg[3] += xv * r0[3]; lg[4] += xv * r1[0]; lg[5] += xv * r1[1]; lg[6] += xv * r1[2]; lg[7] += xv * r1[3]; }
#pragma unroll
            for (int e = 0; e < 8; ++e) lg[e] = wave_sum(lg[e]) + A.in[I_MRB][e];
            int e1 = 0; float v1 = lg[0];
#pragma unroll
            for (int e = 1; e < 8; ++e) if (lg[e] > v1) { v1 = lg[e]; e1 = e; }
            int e2 = -1; float v2 = -3.0e38f;
#pragma unroll
            for (int e = 0; e < 8; ++e) if (e != e1 && lg[e] > v2) { v2 = lg[e]; e2 = e; }
            const float w1 = 1.0f / (1.0f + expf(v2 - v1)), w2 = 1.0f - w1;
            if (lane == 0) { WSP(u32x4, O_TOKI)[r] = (u32x4){(unsigned)e1, (unsigned)e2, __float_as_uint(w1), __float_as_uint(w2)};
                __hip_atomic_fetch_add(sCnt + e1, 1u, __ATOMIC_RELAXED, __HIP_MEMORY_SCOPE_WORKGROUP); __hip_atomic_fetch_add(sCnt + 8 + e2, 1u, __ATOMIC_RELAXED, __HIP_MEMORY_SCOPE_WORKGROUP); }
        }
    }
    if (router) { __syncthreads(); if (tid < 16) WSP(unsigned, O_CTL)[CW_BLK + bidx() * 16 + tid] = sCnt[tid]; }
}

#ifndef ATOMIC_RESID
#define ATOMIC_RESID 0
#endif
using pg8::Unit;
struct EpiInProj {
    static constexpr bool PERM = true;
    bf16* PM; unsigned char* SG8; bf16* GDN; bf16* UH;
    __device__ __forceinline__ void operator()(const f32x4 (&acc)[2][2][4][2], const Unit& u, int wr, int wc, int fr, int fq) const {
        const int row0 = u.pm * 256 + wr * 64 + fr, cc0 = wc * 32 + 8 * fq;
#pragma unroll
        for (int ai = 0; ai < 2; ++ai)
#pragma unroll
            for (int m = 0; m < 4; ++m) { const int row = row0 + ai * 128 + m * 16;
#pragma unroll
                for (int bj = 0; bj < 2; ++bj) { const f32x4 v0 = acc[ai][bj][m][0], v1 = acc[ai][bj][m][1]; const int cc = cc0 + bj * 128;
                    if (u.pn >= 10 && u.pn < 26) { unsigned q[8];
#pragma unroll
                        for (int e = 0; e < 4; ++e) { q[e] = (unsigned)(sigmoid_fast(v0[e]) * 255.0f + 0.5f); q[4 + e] = (unsigned)(sigmoid_fast(v1[e]) * 255.0f + 0.5f); }
                        *(u32x2*)(SG8 + (size_t)row * SGC + (u.pn - 10) * 256 + cc) = (u32x2){q[0] | (q[1] << 8) | (q[2] << 16) | (q[3] << 24), q[4] | (q[5] << 8) | (q[6] << 16) | (q[7] << 24)}; }
                    else { u32x4 w; w.x = pg8::cvt_pk_bf16(v0[0], v0[1]); w.y = pg8::cvt_pk_bf16(v0[2], v0[3]); w.z = pg8::cvt_pk_bf16(v1[0], v1[1]); w.w = pg8::cvt_pk_bf16(v1[2], v1[3]);
                        if (u.pn == 4) { const int g = cc >> 4, h0 = cc & 15; *(u32x4*)(UH + ((size_t)(g * 768 + (row >> 6)) * 1280 + (row & 63) * 16 + h0)) = w; }
                        else if (u.pn < 10) *(u32x4*)(PM + (size_t)row * PMC + u.pn * 256 + cc) = w;
                        else if (cc < 32) *(u32x4*)(GDN + (size_t)row * 32 + cc) = w; } } }
    }
};
struct EpiF32 {
    static constexpr bool PERM = false;
    float* C; int ldc;
    __device__ __forceinline__ void operator()(const f32x4 (&acc)[2][2][4][2], const Unit& u, int wr, int wc, int fr, int fq) const {
        const int row0 = u.pa * 256 + wr * 64 + fr, col0 = u.pn * 256 + wc * 32 + 4 * fq;
#pragma unroll
        for (int ai = 0; ai < 2; ++ai)
#pragma unroll
            for (int m = 0; m < 4; ++m) { float* rowp = C + (size_t)(row0 + ai * 128 + m * 16) * ldc + col0;
#pragma unroll
                for (int bj = 0; bj < 2; ++bj)
#pragma unroll
                    for (int n = 0; n < 2; ++n) *(f32x4*)(rowp + bj * 128 + n * 16) = acc[ai][bj][m][n]; }
    }
};
struct EpiS5Y {
    static constexpr bool PERM = true;
    bf16* GB;
    __device__ __forceinline__ void operator()(const f32x4 (&acc)[2][2][4][2], const Unit& u, int wr, int wc, int fr, int fq) const {
        const int n0 = u.pm * 256 + wr * 64 + fr, g = u.aux;
#pragma unroll
        for (int ai = 0; ai < 2; ++ai)
#pragma unroll
            for (int m = 0; m < 4; ++m) { const int n = n0 + ai * 128 + m * 16; if (n < NCHK) {
#pragma unroll
                for (int bj = 0; bj < 2; ++bj) { const int jp = u.pn * 16 + 8 * bj + 2 * wc + (fq >> 1), h0 = 8 * (fq & 1);
                    const f32x4 v0 = acc[ai][bj][m][0], v1 = acc[ai][bj][m][1];
                    u32x4 w; w.x = pk2(gelu_tanh_fast(v0[0]), gelu_tanh_fast(v0[1])); w.y = pk2(gelu_tanh_fast(v0[2]), gelu_tanh_fast(v0[3])); w.z = pk2(gelu_tanh_fast(v1[0]), gelu_tanh_fast(v1[1])); w.w = pk2(gelu_tanh_fast(v1[2]), gelu_tanh_fast(v1[3]));
                    *(u32x4*)(GB + (size_t)(n * 64 + jp) * 256 + g * 16 + h0) = w; } } }
    }
};
struct EpiGlu {
    static constexpr bool PERM = true;
    const bf16* GB; bf16* O; const float* bias;
    __device__ __forceinline__ void operator()(const f32x4 (&acc)[2][2][4][2], const Unit& u, int wr, int wc, int fr, int fq) const {
        const int row0 = u.pm * 256 + wr * 64 + fr, cc0 = wc * 32 + 8 * fq;
#pragma unroll
        for (int ai = 0; ai < 2; ++ai)
#pragma unroll
            for (int bj = 0; bj < 2; ++bj) { const int cc = cc0 + bj * 128; u32x4 gwv[4];
                const f32x4 b0 = *(const f32x4*)(bias + cc), b1 = *(const f32x4*)(bias + cc + 4);
#pragma unroll
                for (int m = 0; m < 4; ++m) gwv[m] = *(const u32x4*)(GB + (size_t)(row0 + ai * 128 + m * 16) * 256 + cc);
#pragma unroll
                for (int m = 0; m < 4; ++m) { const int row = row0 + ai * 128 + m * 16; const u32x4 gw = gwv[m];
                    const f32x4 v0 = acc[ai][bj][m][0] + b0, v1 = acc[ai][bj][m][1] + b1;
                    u32x4 w; w.x = pk2(bflo(gw.x) * sigmoid_fast(v0[0]), bfhi(gw.x) * sigmoid_fast(v0[1])); w.y = pk2(bflo(gw.y) * sigmoid_fast(v0[2]), bfhi(gw.y) * sigmoid_fast(v0[3]));
                    w.z = pk2(bflo(gw.z) * sigmoid_fast(v1[0]), bfhi(gw.z) * sigmoid_fast(v1[1])); w.w = pk2(bflo(gw.w) * sigmoid_fast(v1[2]), bfhi(gw.w) * sigmoid_fast(v1[3]));
                    *(u32x4*)(O + (size_t)row * 256 + cc) = w; }
                asm volatile("" ::: "memory"); }
    }
};
struct EpiMerge {
    static constexpr bool PERM = false;
    const bf16* SG; float* YMF; bf16* YB;
    __device__ __forceinline__ void operator()(const f32x4 (&acc)[2][2][4][2], const Unit& u, int wr, int wc, int fr, int fq) const {
        const int row0 = u.pm * 256 + wr * 64 + fr, col0 = u.pn * 256 + wc * 32 + 4 * fq, k = u.aux;
#pragma unroll
        for (int ai = 0; ai < 2; ++ai)
#pragma unroll
            for (int m = 0; m < 4; ++m) { const int row = row0 + ai * 128 + m * 16;
#pragma unroll
                for (int bj = 0; bj < 2; ++bj)
#pragma unroll
                    for (int n = 0; n < 2; ++n) { const int col = col0 + bj * 128 + n * 16; const u32x2 sg = *(const u32x2*)(SG + (size_t)row * SGC + k * 1024 + col);
                        f32x4 v = acc[ai][bj][m][n]; v[0] *= bflo(sg.x); v[1] *= bfhi(sg.x); v[2] *= bflo(sg.y); v[3] *= bfhi(sg.y);
                        float* yp = YMF + (size_t)row * DM + col;
                        if (k > 0) v = v + *(const f32x4*)yp;
                        if (k < 3) *(f32x4*)yp = v; else *(u32x2*)(YB + (size_t)row * DM + col) = (u32x2){pk2(v[0], v[1]), pk2(v[2], v[3])}; }
                asm volatile("" ::: "memory"); }
    }
};
struct EpiResid {
    static constexpr bool PERM = true;
    bf16* X; const float* gate; float sc;
    __device__ __forceinline__ void operator()(const f32x4 (&acc)[2][2][4][2], const Unit& u, int wr, int wc, int fr, int fq) const {
        const int cond = u.pm < 128 ? (u.pm >> 5) : 4; bf16* xb = X + (size_t)u.pm * 256 * DM;
        const int row0 = wr * 64 + fr, col0 = u.pn * 256 + wc * 32 + 8 * fq; const float* gp = gate + cond * 6144 + col0;
        f32x4 gv[2][2];
#pragma unroll
        for (int bj = 0; bj < 2; ++bj) { gv[bj][0] = *(const f32x4*)(gp + bj * 128) * sc; gv[bj][1] = *(const f32x4*)(gp + bj * 128 + 4) * sc; }
#pragma unroll
        for (int ai = 0; ai < 2; ++ai) {
            u32x4 xv[4][2];
#pragma unroll
            for (int m = 0; m < 4; ++m)
#pragma unroll
                for (int bj = 0; bj < 2; ++bj) xv[m][bj] = *(const u32x4*)(xb + (size_t)(row0 + ai * 128 + m * 16) * DM + col0 + bj * 128);
#pragma unroll
            for (int m = 0; m < 4; ++m)
#pragma unroll
                for (int bj = 0; bj < 2; ++bj) { const f32x4 v0 = gv[bj][0] * acc[ai][bj][m][0], v1 = gv[bj][1] * acc[ai][bj][m][1]; const u32x4 x = xv[m][bj]; u32x4 o;
                    o.x = pk2(bflo(x.x) + v0[0], bfhi(x.x) + v0[1]); o.y = pk2(bflo(x.y) + v0[2], bfhi(x.y) + v0[3]); o.z = pk2(bflo(x.z) + v1[0], bfhi(x.z) + v1[1]); o.w = pk2(bflo(x.w) + v1[2], bfhi(x.w) + v1[3]);
                    *(u32x4*)(xb + (size_t)(row0 + ai * 128 + m * 16) * DM + col0 + bj * 128) = o; }
            asm volatile("" ::: "memory"); }
    }
};
struct EpiSwiGLU {
    static constexpr bool PERM = true;
    bf16* O; int ldo;
    __device__ __forceinline__ void operator()(const f32x4 (&acc)[2][2][4][2], const Unit& u, int wr, int wc, int fr, int fq) const {
        const int row0 = u.pm * 256 + wr * 64 + fr, col0 = u.pn * 128 + wc * 32 + 8 * fq;
#pragma unroll
        for (int ai = 0; ai < 2; ++ai)
#pragma unroll
            for (int m = 0; m < 4; ++m) { float o[8];
#pragma unroll
                for (int n = 0; n < 2; ++n)
#pragma unroll
                    for (int e = 0; e < 4; ++e) { const float gg = acc[ai][0][m][n][e], uu = acc[ai][1][m][n][e]; o[n * 4 + e] = gg * sigmoid_fast(gg) * uu; }
                u32x4 w; w.x = pg8::cvt_pk_bf16(o[0], o[1]); w.y = pg8::cvt_pk_bf16(o[2], o[3]); w.z = pg8::cvt_pk_bf16(o[4], o[5]); w.w = pg8::cvt_pk_bf16(o[6], o[7]);
                *(u32x4*)(O + (size_t)(row0 + ai * 128 + m * 16) * ldo + col0) = w; }
    }
};
struct EpiSwiGLU8 {
    static constexpr bool PERM = true;
    unsigned char* O; int ldo;
    __device__ __forceinline__ void operator()(const f32x4 (&acc)[2][2][4][2], const Unit& u, int wr, int wc, int fr, int fq) const {
        const int row0 = u.pm * 256 + wr * 64 + fr, col0 = u.pn * 128 + wc * 32 + 8 * fq;
#pragma unroll
        for (int ai = 0; ai < 2; ++ai)
#pragma unroll
            for (int m = 0; m < 4; ++m) { float o[8];
#pragma unroll
                for (int n = 0; n < 2; ++n)
#pragma unroll
                    for (int e = 0; e < 4; ++e) { const float gg = acc[ai][0][m][n][e] * 0.03125f, uu = acc[ai][1][m][n][e] * 0.125f; o[n * 4 + e] = gg * sigmoid_fast(gg) * uu; }
                *(u32x2*)(O + (size_t)(row0 + ai * 128 + m * 16) * ldo + col0) = (u32x2){pack4_fp8(o[0], o[1], o[2], o[3]), pack4_fp8(o[4], o[5], o[6], o[7])}; }
    }
};
struct EpiMoeDown {
    static constexpr bool PERM = false;
    float* XL; const float* gate; const int* rtok; const float* rw; float sc;
    __device__ __forceinline__ void operator()(const f32x4 (&acc)[2][2][4][2], const Unit& u, int wr, int wc, int fr, int fq) const {
        const int row0 = u.pm * 256 + wr * 64 + fr, col0 = u.pn * 256 + wc * 32 + 4 * fq;
#pragma unroll
        for (int ai = 0; ai < 2; ++ai) { int tok[4]; float w[4];
#pragma unroll
            for (int m = 0; m < 4; ++m) { const int row = row0 + ai * 128 + m * 16; tok[m] = rtok[row]; w[m] = rw[row] * sc; }
            f32x4 xv[4][2][2];
            if (!u.split && !ATOMIC_RESID) {
#pragma unroll
                for (int m = 0; m < 4; ++m) if (tok[m] >= 0) {
#pragma unroll
                    for (int bj = 0; bj < 2; ++bj)
#pragma unroll
                        for (int n = 0; n < 2; ++n) xv[m][bj][n] = *(const f32x4*)(XL + (size_t)tok[m] * DM + col0 + bj * 128 + n * 16); } }
#pragma unroll
            for (int m = 0; m < 4; ++m) if (tok[m] >= 0) { const float* gp = gate + (tok[m] >> 13) * 6144 + col0; float* rowp = XL + (size_t)tok[m] * DM + col0;
#pragma unroll
                for (int bj = 0; bj < 2; ++bj)
#pragma unroll
                    for (int n = 0; n < 2; ++n) { float* p = rowp + bj * 128 + n * 16; const f32x4 gv = *(const f32x4*)(gp + bj * 128 + n * 16); const f32x4 v = gv * w[m] * acc[ai][bj][m][n];
                        if (u.split || ATOMIC_RESID) { unsafeAtomicAdd(p, v[0]); unsafeAtomicAdd(p + 1, v[1]); unsafeAtomicAdd(p + 2, v[2]); unsafeAtomicAdd(p + 3, v[3]); } else *(f32x4*)p = xv[m][bj][n] + v; } }
            asm volatile("" ::: "memory"); }
    }
};
struct EpiMoeDelta {
    static constexpr bool PERM = true;
    bf16* D; const float* gate; const int* rtok; const float* rw; float sc;
    __device__ __forceinline__ void operator()(const f32x4 (&acc)[2][2][4][2], const Unit& u, int wr, int wc, int fr, int fq) const {
        const int row0 = u.pm * 256 + wr * 64 + fr, col0 = u.pn * 256 + wc * 32 + 8 * fq;
#pragma unroll
        for (int ai = 0; ai < 2; ++ai)
#pragma unroll
            for (int m = 0; m < 4; ++m) { const int row = row0 + ai * 128 + m * 16; const int tok = rtok[row]; if (tok >= 0) { const float w = rw[row] * sc; const float* gp = gate + (tok >> 13) * 6144 + col0;
#pragma unroll
                for (int bj = 0; bj < 2; ++bj) { const f32x4 g0 = *(const f32x4*)(gp + bj * 128), g1 = *(const f32x4*)(gp + bj * 128 + 4); const f32x4 v0 = acc[ai][bj][m][0] * g0 * w, v1 = acc[ai][bj][m][1] * g1 * w;
                    u32x4 o; o.x = pg8::cvt_pk_bf16(v0[0], v0[1]); o.y = pg8::cvt_pk_bf16(v0[2], v0[3]); o.z = pg8::cvt_pk_bf16(v1[0], v1[1]); o.w = pg8::cvt_pk_bf16(v1[2], v1[3]);
                    *(u32x4*)(D + (size_t)row * DM + col0 + bj * 128) = o; } } }
    }
};
struct OneUnit { bool has; Unit u; __device__ bool next(int i, Unit& o) const { if (i == 0 && has) { o = u; o.k0 = 0; o.nkt = 0; o.split = 0; return true; } return false; } };

struct MoeOrder { int G, c, nN, ntile, pa0; int tb[9];
    __device__ bool next(int i, Unit& u) const { const int L = i * G + c; if (L >= ntile * nN) return false; const int pm = L / nN, pn = L % nN; int e = 0;
#pragma unroll
        for (int q = 1; q < 8; ++q) e += (pm >= tb[q]) ? 1 : 0;
        u.pm = pm; u.pn = pn; u.pa = pa0 + pm; u.pb = e * nN + pn; u.aux = e; u.k0 = 0; u.nkt = 0; u.split = 0; return true; } };
struct Moe2Order { int G, c, nN; int tb0[9], tb1[9];
    __device__ bool next(int i, Unit& u) const { const int T0 = tb0[8], T1 = tb1[8]; const int L = i * G + c; if (L >= (T0 + T1) * nN) return false; const int pg = L / nN, pn = L - pg * nN; const int s = pg >= T0 ? 1 : 0, pl = pg - (s ? T0 : 0); int e = 0;
#pragma unroll
        for (int q = 1; q < 8; ++q) e += (pl >= (s ? tb1[q] : tb0[q])) ? 1 : 0;
        u.pa = s * (MOE_ROWS / 256) + pl; u.pm = u.pa; u.pn = pn; u.pb = e * nN + pn; u.aux = e; u.k0 = 0; u.nkt = 0; u.split = 0; return true; } };
struct SplitOrder { int G, c, U, KT, pa0, moe, smax; int tb[9];
    __device__ bool next(int i, Unit& u) const { const int R = U / G, rem = U - R * G; int S = 1; if (rem > 0 && rem * 2 <= G) { S = G / rem; if (S > smax) S = smax; if (S > KT / 2) S = KT / 2; }
        int L, part = 0; if (i < R) L = i * G + c; else if (i == R && c < rem * S) { L = R * G + c / S; part = c - (c / S) * S; } else return false;
        const int pm = L >> 2, pn = L & 3; int e = 0;
        if (moe) {
#pragma unroll
            for (int q = 1; q < 8; ++q) e += (pm >= tb[q]) ? 1 : 0; }
        u.pm = pm; u.pn = pn; u.pa = pa0 + pm; u.pb = e * 4 + pn; u.aux = e;
        if (i == R && S > 1) { const int pairs = KT / 2, p0 = (part * pairs) / S, p1 = ((part + 1) * pairs) / S; u.k0 = 2 * p0; u.nkt = 2 * (p1 - p0); u.split = 1; } else { u.k0 = 0; u.nkt = 0; u.split = 0; }
        return true; } };

__device__ __forceinline__ void s5_tables(CArgs& A) {
    f32x2* PW = WSP(f32x2, O_S5PW); f32x2* Q = WSP(f32x2, O_S5Q);
    for (int i = bidx() * NTHR + tidx(); i < 2 * 16 * 2 * 65 * 64; i += gdim() * NTHR) {
        const int p = i & 63, e = (i >> 6) % 65, lgd = i / (65 * 64), d = lgd & 1, g = (lgd >> 1) & 15, l = lgd >> 5; const int pb = (l * 2 + d) * 16 + g;
        const double dt = exp((double)A.in[I_LDT][pb]); const double lre = fmin((double)A.in[I_LRE][pb * 64 + p], -1e-4), lim = (double)A.in[I_LIM][pb * 64 + p];
        const double mag = exp(lre * dt * e); double sn, cs; sincos(lim * dt * e, &sn, &cs);
        PW[i] = (f32x2){(float)(mag * cs), (float)(mag * sn)};
        if (e == 1) { const double nr = mag * cs - 1.0, ni = mag * sn, den = lre * lre + lim * lim; Q[lgd * 64 + p] = (f32x2){(float)((nr * lre + ni * lim) / den), (float)((ni * lre - nr * lim) / den)}; }
    }
}
__device__ __forceinline__ void s5_ktable_unit(CArgs& A, LAS unsigned char* lds, int uq) {
    const int tid = tidx(); LAS float* sK = (LAS float*)lds;
    LAS double* sL = (LAS double*)(lds + 16384);
    LAS float* sB = (LAS float*)(lds + 20480);
    LAS float* sC = (LAS float*)(lds + 28672);
    const int mq = uq & 3, u = uq >> 2, d = u & 1, g = (u >> 1) & 15, l = u >> 5, pb = (l * 2 + d) * 16 + g; const int ph = tid >> 8, hp = (tid >> 4) & 15, h = tid & 15;
    for (int i = tid; i < 1024; i += NTHR) { sB[i] = A.in[I_BRE][pb * 1024 + i]; sB[1024 + i] = A.in[I_BIM][pb * 1024 + i];
        const int r = i >> 6, c = i & 63; sC[r * 65 + c] = A.in[I_CRE][pb * 1024 + i]; sC[1040 + r * 65 + c] = A.in[I_CIM][pb * 1024 + i]; }
    if (tid < 64) { const int p = tid; const double dt = exp((double)A.in[I_LDT][pb]);
        const double lre = fmin((double)A.in[I_LRE][pb * 64 + p], -1e-4), lim = (double)A.in[I_LIM][pb * 64 + p];
        const double er = exp(lre * dt); double sn, cs; sincos(lim * dt, &sn, &cs); const double lbr = er * cs, lbi = er * sn;
        const double nr = lbr - 1.0, ni = lbi, den = lre * lre + lim * lim; const double qr = (nr * lre + ni * lim) / den, qi = (ni * lre - nr * lim) / den;
        const double e0 = (double)(16 * mq); const double er0 = exp(lre * dt * e0); double sn0, cs0; sincos(lim * dt * e0, &sn0, &cs0);
        sL[p * 6 + 0] = lbr; sL[p * 6 + 1] = lbi; sL[p * 6 + 2] = qr; sL[p * 6 + 3] = qi; sL[p * 6 + 4] = er0 * cs0; sL[p * 6 + 5] = er0 * sn0; }
    __syncthreads();
    float acc[16];
#pragma unroll
    for (int m = 0; m < 16; ++m) acc[m] = 0.f;
    for (int p = ph * 32; p < ph * 32 + 32; ++p) {
        const double lbr = sL[p * 6 + 0], lbi = sL[p * 6 + 1], qr = sL[p * 6 + 2], qi = sL[p * 6 + 3], pr = sL[p * 6 + 4], pi = sL[p * 6 + 5];
        const double br_ = (double)sB[p * 16 + h], bi_ = (double)sB[1024 + p * 16 + h];
        const double bbr = qr * br_ - qi * bi_, bbi = qr * bi_ + qi * br_;
        const double cr = (double)sC[hp * 65 + p], ci = (double)sC[1040 + hp * 65 + p];
        const double c0r = cr * bbr - ci * bbi, c0i = cr * bbi + ci * bbr;
        float cur_r = (float)(c0r * pr - c0i * pi), cur_i = (float)(c0r * pi + c0i * pr); const float wr_ = (float)lbr, wi_ = (float)lbi;
#pragma unroll
        for (int m = 0; m < 16; ++m) { acc[m] += cur_r; const float t = cur_r * wr_ - cur_i * wi_; cur_i = cur_r * wi_ + cur_i * wr_; cur_r = t; }
    }
    if (ph == 1) {
#pragma unroll
        for (int m = 0; m < 16; ++m) sK[m * 256 + hp * 16 + h] = acc[m]; }
    __syncthreads();
    if (ph == 0) { float* KT = WSP(float, O_S5K) + ((size_t)u * 64 + mq * 16) * 256;
#pragma unroll
        for (int m = 0; m < 16; ++m) KT[m * 256 + hp * 16 + h] = acc[m] + sK[m * 256 + hp * 16 + h]; }
    __syncthreads();
}
__device__ __forceinline__ void s5_fill_unit(CArgs& A, int l, int u) {
    const int tid = tidx(), g = u >> 4, sl = u & 15;
    const float* KF = WSP(float, O_S5K) + (size_t)(((l * 16 + g) * 2 + 0)) * 64 * 256; const float* KB = KF + 64 * 256;
    const f32x2* PW = WSP(f32x2, O_S5PW) + (size_t)((l * 16 + g) * 2) * 65 * 64; const f32x2* Q = WSP(f32x2, O_S5Q) + (size_t)((l * 16 + g) * 2) * 64;
    bf16* TC = WSP(bf16, O_TCM) + (size_t)g * 1024 * 1280;
    for (int idx = tid; idx < 64 * 128; idx += NTHR) { const int row = sl * 64 + (idx >> 7), cg = idx & 127, jp = row >> 4, hp = row & 15, j = cg >> 1, h0 = (cg & 1) * 8; float v[8];
        if (jp != j) { const float* kp = (jp > j ? KF + (jp - j) * 256 : KB + (j - jp) * 256) + hp * 16 + h0; const f32x4 a = *(const f32x4*)kp, b = *(const f32x4*)(kp + 4);
            v[0] = a[0]; v[1] = a[1]; v[2] = a[2]; v[3] = a[3]; v[4] = b[0]; v[5] = b[1]; v[6] = b[2]; v[7] = b[3]; }
        else {
#pragma unroll
            for (int e = 0; e < 8; ++e) { const int h = h0 + e; v[e] = KF[hp * 16 + h] + KB[hp * 16 + h] + (hp == h ? A.in[I_S5D][(l * 16 + g) * 16 + h] : 0.f); } }
        *(u32x4*)(TC + (size_t)row * 1280 + j * 16 + h0) = (u32x4){pk2(v[0], v[1]), pk2(v[2], v[3]), pk2(v[4], v[5]), pk2(v[6], v[7])}; }
    for (int idx = tid; idx < 64 * 16; idx += NTHR) { const int p0 = (idx & 7) * 8, d = (idx >> 3) & 1, row = sl * 64 + (idx >> 4), jp = row >> 4, hp = row & 15;
        const int e = d == 0 ? jp + 1 : 64 - jp; const int pb = (l * 2 + d) * 16 + g;
        const f32x4* wp = (const f32x4*)(PW + (d * 65 + e) * 64 + p0); const f32x4 w01 = wp[0], w23 = wp[1], w45 = wp[2], w67 = wp[3];
        const float* crp = A.in[I_CRE] + (size_t)(pb * 16 + hp) * 64 + p0; const float* cip = A.in[I_CIM] + (size_t)(pb * 16 + hp) * 64 + p0;
        const f32x4 cr0 = *(const f32x4*)crp, cr1 = *(const f32x4*)(crp + 4), ci0 = *(const f32x4*)cip, ci1 = *(const f32x4*)(cip + 4);
        const float wx[8] = {w01[0], w01[2], w23[0], w23[2], w45[0], w45[2], w67[0], w67[2]}, wy[8] = {w01[1], w01[3], w23[1], w23[3], w45[1], w45[3], w67[1], w67[3]};
        const float cr[8] = {cr0[0], cr0[1], cr0[2], cr0[3], cr1[0], cr1[1], cr1[2], cr1[3]}, ci[8] = {ci0[0], ci0[1], ci0[2], ci0[3], ci1[0], ci1[1], ci1[2], ci1[3]};
        float re[8], im[8];
#pragma unroll
        for (int k = 0; k < 8; ++k) { re[k] = cr[k] * wx[k] - ci[k] * wy[k]; im[k] = -(cr[k] * wy[k] + ci[k] * wx[k]); }
        bf16* o = TC + (size_t)row * 1280 + 1024 + d * 128 + p0;
        *(u32x4*)o = (u32x4){pk2(re[0], re[1]), pk2(re[2], re[3]), pk2(re[4], re[5]), pk2(re[6], re[7])};
        *(u32x4*)(o + 64) = (u32x4){pk2(im[0], im[1]), pk2(im[2], im[3]), pk2(im[4], im[5]), pk2(im[6], im[7])}; }
    bf16* BP = WSP(bf16, O_BPOW) + (size_t)g * 256 * 1024;
    for (int idx = tid; idx < 16 * 128; idx += NTHR) { const int h0 = (idx & 1) * 8, j = (idx >> 1) & 63, row = sl * 16 + (idx >> 7), d = row >> 7, ri = (row >> 6) & 1, p = row & 63;
        const int e = d == 0 ? 63 - j : j; const f32x2 w = PW[(d * 65 + e) * 64 + p], q = Q[d * 64 + p]; const int pb = (l * 2 + d) * 16 + g;
        const float* brp = A.in[I_BRE] + (size_t)(pb * 64 + p) * 16 + h0; const float* bip = A.in[I_BIM] + (size_t)(pb * 64 + p) * 16 + h0;
        const f32x4 br0 = *(const f32x4*)brp, br1 = *(const f32x4*)(brp + 4), bi0 = *(const f32x4*)bip, bi1 = *(const f32x4*)(bip + 4);
        const float br[8] = {br0[0], br0[1], br0[2], br0[3], br1[0], br1[1], br1[2], br1[3]}, bi[8] = {bi0[0], bi0[1], bi0[2], bi0[3], bi1[0], bi1[1], bi1[2], bi1[3]};
        float v[8];
#pragma unroll
        for (int k = 0; k < 8; ++k) { const float bbr = q.x * br[k] - q.y * bi[k], bbi = q.x * bi[k] + q.y * br[k]; v[k] = ri == 0 ? (w.x * bbr - w.y * bbi) : (w.x * bbi + w.y * bbr); }
        *(u32x4*)(BP + (size_t)row * 1024 + j * 16 + h0) = (u32x4){pk2(v[0], v[1]), pk2(v[2], v[3]), pk2(v[4], v[5]), pk2(v[6], v[7])}; }
}

constexpr int GT = 72;
__device__ __forceinline__ u32x4 pack8(const float (&v)[8]) { return (u32x4){pk2(v[0], v[1]), pk2(v[2], v[3]), pk2(v[4], v[5]), pk2(v[6], v[7])}; }
template <int D>
__device__ __forceinline__ void gla_prep_a(CArgs& A, int l, int hd, const LAS float* sG, LAS float* sGs, int lane, int jg, float (&c)[8]) {
    float wu[16];
#pragma unroll
    for (int r = 0; r < 16; ++r) wu[r] = A.in[I_GWUP][((l * 2 + D) * 16 + r) * 256 + hd * 64 + lane];
    const float bu = A.in[I_GBUP][(l * 2 + D) * 256 + hd * 64 + lane];
#pragma unroll
    for (int i = 0; i < 8; ++i) { const int j = jg * 8 + i; float z = bu;
#pragma unroll
        for (int r = 0; r < 16; ++r) z += sG[j * 32 + 16 * D + r] * wu[r];
        c[i] = (fminf(z, 0.f) - __logf(1.0f + __expf(-fabsf(z)))) * 0.0625f; }
    if (D == 0) {
#pragma unroll
        for (int i = 1; i < 8; ++i) c[i] += c[i - 1]; }
    else {
#pragma unroll
        for (int i = 6; i >= 0; --i) c[i] += c[i + 1]; }
    sGs[(D * 8 + jg) * 64 + lane] = D == 0 ? c[7] : c[0];
}
template <int D>
__device__ __forceinline__ void gla_prep_b(const LAS float* sGs, int lane, int jg, float (&c)[8], float& tot) {
    float off = 0.f, t = 0.f;
#pragma unroll
    for (int g = 0; g < 8; ++g) { const float v = sGs[(D * 8 + g) * 64 + lane]; t += v; off += (D == 0 ? (g < jg) : (g > jg)) ? v : 0.f; }
#pragma unroll
    for (int i = 0; i < 8; ++i) c[i] += off;
    tot = t;
}
__device__ __forceinline__ void gla_load_gdn(const bf16* GDN, int r0, LAS float* sG, int tid) {
    if (tid < 256) { const int j = tid >> 2, seg = tid & 3; const u32x4 w = *(const u32x4*)(GDN + (size_t)(r0 + j) * 32 + seg * 8); LAS float* o = sG + j * 32 + seg * 8;
        o[0] = bflo(w.x); o[1] = bfhi(w.x); o[2] = bflo(w.y); o[3] = bfhi(w.y); o[4] = bflo(w.z); o[5] = bfhi(w.z); o[6] = bflo(w.w); o[7] = bfhi(w.w); }
}
__device__ __forceinline__ void tile_mma(f32x16& acc, const LAS bf16* X, const LAS bf16* Y, int tm, int tn, int lane) {
    const int r = lane & 31, h = lane >> 5; const LAS bf16* xp = X + (32 * tm + r) * GT + 8 * h; const LAS bf16* yp = Y + (32 * tn + r) * GT + 8 * h;
#pragma unroll
    for (int s = 0; s < 4; ++s) { const bf16x8 a = *(const LAS bf16x8*)(xp + 16 * s), b = *(const LAS bf16x8*)(yp + 16 * s); acc = __builtin_amdgcn_mfma_f32_32x32x16_bf16(a, b, acc, 0, 0, 0); }
}
__device__ __forceinline__ void gla_local_unit(CArgs& A, LAS unsigned char* lds, int l, int n, int hd) {
    const int tid = tidx(), lane = tid & 63, jg = tid >> 6; const int r0 = n * 64;
    LAS bf16* sVT = (LAS bf16*)lds; LAS bf16* sKo = sVT + 64 * GT;
    LAS float* sG = (LAS float*)(lds + 3 * 64 * GT * 2); LAS float* sGs = sG + 2048;
    const bf16* PM = WSP(bf16, O_PM);
    gla_load_gdn(WSP(bf16, O_GDN), r0, sG, tid);
    float kv[8], vv[8];
#pragma unroll
    for (int i = 0; i < 8; ++i) { const size_t ro = (size_t)(r0 + jg * 8 + i) * PMC + hd * 64 + lane; kv[i] = bf2f(PM[ro + 256]); vv[i] = bf2f(PM[ro + 512]); }
    *(LAS u32x4*)(sVT + lane * GT + 8 * jg) = pack8(vv);
    __syncthreads();
    float* DEC = WSP(float, O_GDEC);
    float c0[8], c1[8], tot0, tot1;
    gla_prep_a<0>(A, l, hd, sG, sGs, lane, jg, c0); gla_prep_a<1>(A, l, hd, sG, sGs, lane, jg, c1);
    __syncthreads();
    gla_prep_b<0>(sGs, lane, jg, c0, tot0); gla_prep_b<1>(sGs, lane, jg, c1, tot1);
    { const float (&c)[8] = c0; const float tot = tot0; float ko[8];
#pragma unroll
      for (int i = 0; i < 8; ++i) ko[i] = kv[i] * __expf(tot - c[i]);
      *(LAS u32x4*)(sKo + lane * GT + 8 * jg) = pack8(ko); if (jg == 0) DEC[((hd * 2 + 0) * NCHK + n) * 64 + lane] = __expf(tot); }
    { const float (&c)[8] = c1; const float tot = tot1; float ko[8];
#pragma unroll
      for (int i = 0; i < 8; ++i) ko[i] = kv[i] * __expf(tot - c[i]);
      *(LAS u32x4*)(sKo + 64 * GT + lane * GT + 8 * jg) = pack8(ko); if (jg == 0) DEC[((hd * 2 + 1) * NCHK + n) * 64 + lane] = __expf(tot); }
    __syncthreads();
    { const int d = jg >> 2, tm = (jg >> 1) & 1, tn = jg & 1; f32x16 acc;
#pragma unroll
      for (int i = 0; i < 16; ++i) acc[i] = 0.f;
      tile_mma(acc, sVT, sKo + d * 64 * GT, tm, tn, lane);
      float* sp = WSP(float, O_H) + ((size_t)((hd * 2 + d) * NCHK + n)) * 4096 + 32 * tn + (lane & 31);
#pragma unroll
      for (int i = 0; i < 16; ++i) { const int dv = 32 * tm + (i & 3) + 8 * (i >> 2) + 4 * (lane >> 5); sp[dv * 64] = acc[i]; } }
    __syncthreads();
}
__device__ __forceinline__ void gla_carry(CArgs& A) {
    const float* ST = WSP(float, O_H); const float* DEC = WSP(float, O_GDEC); bf16* SB = WSP(bf16, O_GS16);
    for (int e = bidx() * NTHR + tidx(); e < 131072; e += gdim() * NTHR) {
        const int dk = e & 63, el = e & 4095, chain = e >> 12, b = chain & 3, hd = (chain >> 2) & 3, d = chain >> 4; const int base = (hd * 2 + d) * NCHK;
        float s = 0.f;
        for (int st = 0; st < 132; st += 12) { float tmp[12], dec[12]; unsigned ix[12];
#pragma unroll
            for (int q = 0; q < 12; ++q) { const int n = seq_chunk(b, d, st + q); ix[q] = (unsigned)(base + n) * 4096u + (unsigned)el; tmp[q] = ST[ix[q]]; dec[q] = DEC[(base + n) * 64 + dk]; }
#pragma unroll
            for (int q = 0; q < 12; ++q) { SB[ix[q]] = (bf16)f2bf(s); s = dec[q] * s + tmp[q]; } }
    }
}
template <int D>
__device__ __forceinline__ void gla_out_prep(CArgs& A, int hd, int n, const float (&c)[8], LAS bf16* sQi, LAS bf16* sKi, LAS bf16* sST, const float (&qv)[8], const float (&kv)[8], int tid) {
    const int lane = tid & 63, jg = tid >> 6;
#pragma unroll
    for (int i = 0; i < 8; ++i) { const int j = jg * 8 + i; sQi[j * GT + lane] = (bf16)f2bf(qv[i] * 0.125f * __expf(c[i])); sKi[j * GT + lane] = (bf16)f2bf(kv[i] * __expf(-c[i])); }
    *(LAS u32x4*)(sST + (tid >> 3) * GT + (tid & 7) * 8) = *(const u32x4*)(WSP(bf16, O_GS16) + ((size_t)((hd * 2 + D) * NCHK + n)) * 4096 + tid * 8);
}
__device__ __forceinline__ void gla_out_unit(CArgs& A, LAS unsigned char* lds, int l, int n, int hd) {
    const int tid = tidx(), lane = tid & 63, jg = tid >> 6; const int r0 = n * 64;
    LAS bf16* T = (LAS bf16*)lds; constexpr int TS = 64 * GT;
    LAS float* sG = (LAS float*)(lds + 9 * TS * 2); LAS float* sGs = sG + 2048; LAS float* sO = sGs + 1024;
    const bf16* PM = WSP(bf16, O_PM);
    gla_load_gdn(WSP(bf16, O_GDN), r0, sG, tid);
    float qv[8], kv[8], vv[8]; bf16 ogr[8];
#pragma unroll
    for (int i = 0; i < 8; ++i) { const size_t ro = (size_t)(r0 + jg * 8 + i) * PMC + hd * 64 + lane; qv[i] = bf2f(PM[ro]); kv[i] = bf2f(PM[ro + 256]); vv[i] = bf2f(PM[ro + 512]); ogr[i] = PM[ro + 768]; }
    *(LAS u32x4*)(T + lane * GT + 8 * jg) = pack8(vv);
    __syncthreads();
    { float c0[8], c1[8], tot0, tot1;
      gla_prep_a<0>(A, l, hd, sG, sGs, lane, jg, c0); gla_prep_a<1>(A, l, hd, sG, sGs, lane, jg, c1);
      __syncthreads();
      gla_prep_b<0>(sGs, lane, jg, c0, tot0); gla_prep_b<1>(sGs, lane, jg, c1, tot1);
      gla_out_prep<0>(A, hd, n, c0, T + 1 * TS, T + 2 * TS, T + 4 * TS, qv, kv, tid);
      gla_out_prep<1>(A, hd, n, c1, T + 5 * TS, T + 6 * TS, T + 8 * TS, qv, kv, tid); }
    __syncthreads();
    const int d = jg >> 2, tm = (jg >> 1) & 1, tn = jg & 1, cl = lane & 31, hh = lane >> 5;
    { f32x16 acc;
#pragma unroll
      for (int i = 0; i < 16; ++i) acc[i] = 0.f;
      tile_mma(acc, T + (1 + 4 * d) * TS, T + (2 + 4 * d) * TS, tm, tn, lane);
      LAS bf16* at = T + (3 + 4 * d) * TS; const int j = 32 * tn + cl;
#pragma unroll
      for (int i = 0; i < 16; ++i) { const int ii = 32 * tm + (i & 3) + 8 * (i >> 2) + 4 * hh; const bool keep = d ? (j >= ii) : (j <= ii); at[ii * GT + j] = (bf16)f2bf(keep ? acc[i] : 0.f); } }
    __syncthreads();
    { f32x16 acc;
#pragma unroll
      for (int i = 0; i < 16; ++i) acc[i] = 0.f;
      tile_mma(acc, T + (3 + 4 * d) * TS, T, tm, tn, lane);
      tile_mma(acc, T + (1 + 4 * d) * TS, T + (4 + 4 * d) * TS, tm, tn, lane);
      const int dv = 32 * tn + cl; LAS float* so = sO + d * (64 * 65);
#pragma unroll
      for (int i = 0; i < 16; ++i) so[(32 * tm + (i & 3) + 8 * (i >> 2) + 4 * hh) * 65 + dv] = acc[i]; }
    __syncthreads();
    bf16* BR0 = WSP(bf16, O_BR);
#pragma unroll
    for (int i = 0; i < 8; ++i) { const int row = jg * 8 + i; const float o = sO[row * 65 + lane] + sO[64 * 65 + row * 65 + lane]; const float ssq = wave_sum(o * o); const float rstd = 1.0f / sqrtf(ssq * (1.0f / 64.0f) + EPS);
        const float og = bf2f(ogr[i]);
        BR0[(size_t)(r0 + row) * 256 + hd * 64 + lane] = (bf16)f2bf(o * rstd * og * sigmoid_fast(og)); }
    __syncthreads();
}

__device__ __forceinline__ void merge_unit(CArgs& A, LAS unsigned char* lds, int l, int pm, int pn) {
    const int tid = tidx(), lane = tid & 63, wave = tid >> 6, wr = wave >> 2, wc = wave & 3, fr = lane & 15, fq = lane >> 4;
    constexpr int ABYTES = 128 * GT * 2, BBYTES = 256 * GT * 2, SLOT = ABYTES + BBYTES;
    const bf16* BR = WSP(bf16, O_BR); const bf16* WB = WSP(bf16, O_WBR) + (size_t)l * 4 * 1024 * 256; const unsigned char* SG = WSP(unsigned char, O_SG);
    const int arow = tid >> 3, aseg = tid & 7;
    const bf16* ag = BR + (size_t)(pm * 128 + arow) * 256 + aseg * 8; const bf16* bg = WB + (size_t)(pn * 256 + (arow & ~31) + pg8::perm32(arow & 31)) * 256 + aseg * 8;
    u32x4 ast[2][2], bst[4];
#define MRG_LOADA(t, q) do { const int _k = (t) >> 2, _kt = (t) & 3; const bf16* _a = ag + (size_t)_k * TT * 256 + _kt * 64; ast[q][0] = *(const u32x4*)_a; ast[q][1] = *(const u32x4*)(_a + 64 * 256); } while (0)
#define MRG_LOADB(t) do { const int _k = (t) >> 2, _kt = (t) & 3; const bf16* _b = bg + (size_t)_k * 1024 * 256 + _kt * 64; \
        _Pragma("unroll") for (int _i = 0; _i < 4; ++_i) bst[_i] = *(const u32x4*)(_b + (size_t)_i * 64 * 256); } while (0)
#define MRG_STORE(slot, q) do { LAS unsigned char* _s = lds + (slot) * SLOT; \
        *(LAS u32x4*)(_s + (arow * GT + aseg * 8) * 2) = ast[q][0]; *(LAS u32x4*)(_s + ((arow + 64) * GT + aseg * 8) * 2) = ast[q][1]; \
        _Pragma("unroll") for (int _i = 0; _i < 4; ++_i) *(LAS u32x4*)(_s + ABYTES + ((arow + 64 * _i) * GT + aseg * 8) * 2) = bst[_i]; } while (0)
    f32x4 acc[4][4], ys[4][4]; u32x2 sgr[4][2];
#pragma unroll
    for (int m = 0; m < 4; ++m)
#pragma unroll
        for (int n = 0; n < 4; ++n) { acc[m][n] = (f32x4){0.f, 0.f, 0.f, 0.f}; ys[m][n] = (f32x4){0.f, 0.f, 0.f, 0.f}; }
    MRG_LOADA(0, 0); MRG_LOADB(0); MRG_LOADA(1, 1); MRG_STORE(0, 0);
    __syncthreads();
#define MRG_STEP(t, q) do {   \
        if ((t) + 2 < 16) MRG_LOADA((t) + 2, 1 - (q)); if ((t) + 1 < 16) MRG_LOADB((t) + 1); \
        if (((t) & 3) == 3) { const int k = (t) >> 2; int fr2 = fr, fq2 = fq; asm volatile("" : "+v"(fr2), "+v"(fq2)); const int row0 = pm * 128 + wr * 64 + fr2, col0 = pn * 256 + wc * 64 + 8 * fq2;     \
            _Pragma("unroll") for (int m = 0; m < 4; ++m) _Pragma("unroll") for (int j = 0; j < 2; ++j) sgr[m][j] = *(const u32x2*)(SG + (size_t)(row0 + 16 * m) * SGC + k * 1024 + col0 + 32 * j); } \
        const LAS bf16* sA = (const LAS bf16*)(lds + ((t) & 1) * SLOT) + (wr * 64 + fr) * GT + 8 * fq; const LAS bf16* sB = (const LAS bf16*)(lds + ((t) & 1) * SLOT + ABYTES) + (wc * 64 + fr) * GT + 8 * fq; \
        _Pragma("unroll") for (int s2 = 0; s2 < 2; ++s2) { bf16x8 af[4]; \
            _Pragma("unroll") for (int m = 0; m < 4; ++m) af[m] = *(const LAS bf16x8*)(sA + m * 16 * GT + 32 * s2); \
            _Pragma("unroll") for (int n = 0; n < 4; ++n) { const bf16x8 bfg = *(const LAS bf16x8*)(sB + n * 16 * GT + 32 * s2); \
                _Pragma("unroll") for (int m = 0; m < 4; ++m) acc[m][n] = __builtin_amdgcn_mfma_f32_16x16x32_bf16(bfg, af[m], acc[m][n], 0, 0, 0); } } \
        if (((t) & 3) == 3) { \
            _Pragma("unroll") for (int m = 0; m < 4; ++m) _Pragma("unroll") for (int j = 0; j < 2; ++j) { const u32x2 sg = sgr[m][j]; const float i255 = 1.0f / 255.0f; \
                ys[m][2 * j][0] += acc[m][2 * j][0] * ((float)(sg.x & 255u) * i255); ys[m][2 * j][1] += acc[m][2 * j][1] * ((float)((sg.x >> 8) & 255u) * i255); ys[m][2 * j][2] += acc[m][2 * j][2] * ((float)((sg.x >> 16) & 255u) * i255); ys[m][2 * j][3] += acc[m][2 * j][3] * ((float)(sg.x >> 24) * i255); \
                ys[m][2 * j + 1][0] += acc[m][2 * j + 1][0] * ((float)(sg.y & 255u) * i255); ys[m][2 * j + 1][1] += acc[m][2 * j + 1][1] * ((float)((sg.y >> 8) & 255u) * i255); ys[m][2 * j + 1][2] += acc[m][2 * j + 1][2] * ((float)((sg.y >> 16) & 255u) * i255); ys[m][2 * j + 1][3] += acc[m][2 * j + 1][3] * ((float)(sg.y >> 24) * i255); \
                acc[m][2 * j] = (f32x4){0.f, 0.f, 0.f, 0.f}; acc[m][2 * j + 1] = (f32x4){0.f, 0.f, 0.f, 0.f}; } } \
        if ((t) + 1 < 16) MRG_STORE(((t) + 1) & 1, q); \
        __syncthreads(); } while (0)
    for (int k4 = 0; k4 < 16; k4 += 4) { MRG_STEP(k4, 1); MRG_STEP(k4 + 1, 0); MRG_STEP(k4 + 2, 1); MRG_STEP(k4 + 3, 0); }
#undef MRG_STEP
    bf16* YB = WSP(bf16, O_H); const int row0 = pm * 128 + wr * 64 + fr, col0 = pn * 256 + wc * 64 + 8 * fq;
#pragma unroll
    for (int m = 0; m < 4; ++m)
#pragma unroll
        for (int j = 0; j < 2; ++j) *(u32x4*)(YB + (size_t)(row0 + 16 * m) * DM + col0 + 32 * j) = (u32x4){pk2(ys[m][2 * j][0], ys[m][2 * j][1]), pk2(ys[m][2 * j][2], ys[m][2 * j][3]), pk2(ys[m][2 * j + 1][0], ys[m][2 * j + 1][1]), pk2(ys[m][2 * j + 1][2], ys[m][2 * j + 1][3])};
#undef MRG_LOADA
#undef MRG_LOADB
#undef MRG_STORE
}

__device__ __forceinline__ void rg_conv_unit(CArgs& A, int l, int n) {
    const int tid = tidx(); const bf16* PM = WSP(bf16, O_PM); bf16* XC = WSP(bf16, O_XC); const int r0 = n * 64; int s0, s1; seq_bounds(n, s0, s1);
    const int c0 = (tid & 31) * 8, tq = tid >> 5; float wc[4][8];
#pragma unroll
    for (int k = 0; k < 4; ++k) { const float* wp = A.in[I_RWC] + (l * 4 + k) * 256 + c0; const f32x4 a = *(const f32x4*)wp, b = *(const f32x4*)(wp + 4);
        wc[k][0] = a[0]; wc[k][1] = a[1]; wc[k][2] = a[2]; wc[k][3] = a[3]; wc[k][4] = b[0]; wc[k][5] = b[1]; wc[k][6] = b[2]; wc[k][7] = b[3]; }
    u32x4 xr[4][4];
#pragma unroll
    for (int i = 0; i < 4; ++i)
#pragma unroll
        for (int k = 0; k < 4; ++k) { const int rr = r0 + tq + 16 * i + k - 2; const int rc = min(max(rr, s0), s1 - 1); const u32x4 v = *(const u32x4*)(PM + (size_t)rc * PMC + 2048 + c0);
            xr[i][k] = (rr >= s0 && rr < s1) ? v : (u32x4){0u, 0u, 0u, 0u}; }
#pragma unroll
    for (int i = 0; i < 4; ++i) { float o[8];
#pragma unroll
        for (int e = 0; e < 8; ++e) o[e] = 0.f;
#pragma unroll
        for (int k = 0; k < 4; ++k) { const u32x4 x = xr[i][k];
            o[0] += wc[k][0] * bflo(x.x); o[1] += wc[k][1] * bfhi(x.x); o[2] += wc[k][2] * bflo(x.y); o[3] += wc[k][3] * bfhi(x.y);
            o[4] += wc[k][4] * bflo(x.z); o[5] += wc[k][5] * bfhi(x.z); o[6] += wc[k][6] * bflo(x.w); o[7] += wc[k][7] * bfhi(x.w); }
        *(u32x4*)(XC + (size_t)(r0 + tq + 16 * i) * 256 + c0) = (u32x4){pk2(o[0], o[1]), pk2(o[2], o[3]), pk2(o[4], o[5]), pk2(o[6], o[7])}; }
}
struct EpiRG {
    static constexpr bool PERM = true;
    const bf16* XC; bf16* LA; bf16* BT; const float* ba; const float* bx; const float* sp;
    __device__ __forceinline__ void operator()(const f32x4 (&acc)[2][2][4][2], const Unit& u, int wr, int wc, int fr, int fq) const {
        const int d = u.pn >> 1, ch0 = (u.pn & 1) * 128 + wc * 32 + 8 * fq, row0 = u.pm * 256 + wr * 64 + fr;
#pragma unroll
        for (int ai = 0; ai < 2; ++ai)
#pragma unroll
            for (int n = 0; n < 2; ++n) { const int cc = d * 256 + ch0 + 4 * n;
                const f32x4 bav = *(const f32x4*)(ba + cc), bxv = *(const f32x4*)(bx + cc), spv = *(const f32x4*)(sp + cc); u32x2 xw[4];
#pragma unroll
                for (int m = 0; m < 4; ++m) xw[m] = *(const u32x2*)(XC + (size_t)(row0 + ai * 128 + m * 16) * 256 + ch0 + 4 * n);
#pragma unroll
                for (int m = 0; m < 4; ++m) { const int row = row0 + ai * 128 + m * 16; const size_t o = ((size_t)d * TT + row) * 256 + ch0;
                    const float xc[4] = {bflo(xw[m].x), bfhi(xw[m].x), bflo(xw[m].y), bfhi(xw[m].y)}; float la[4], bt[4];
#pragma unroll
                    for (int e = 0; e < 4; ++e) { const float r = sigmoid_fast(acc[ai][0][m][n][e] + bav[e]), ig = sigmoid_fast(acc[ai][1][m][n][e] + bxv[e]);
                        la[e] = -8.0f * r * spv[e]; const float a = __expf(la[e]); bt[e] = sqrtf(fmaxf(1.0f - a * a, 0.f)) * ig * xc[e]; }
                    *(u32x2*)(LA + o + 4 * n) = (u32x2){pk2(la[0], la[1]), pk2(la[2], la[3])};
                    *(u32x2*)(BT + o + 4 * n) = (u32x2){pk2(bt[0], bt[1]), pk2(bt[2], bt[3])}; }
                asm volatile("" ::: "memory"); }
    }
};
template <bool OUT>
__device__ __forceinline__ void rg_scan_unit(CArgs& A, LAS unsigned char* lds, int l, int n) {
    const int tid = tidx(); LAS float* sY = (LAS float*)lds; const int r0 = n * 64, ch = tid & 255, d = tid >> 8;
    const bf16* LA = WSP(bf16, O_RLA) + ((size_t)d * TT + r0) * 256 + ch; const bf16* BT = WSP(bf16, O_RBT) + ((size_t)d * TT + r0) * 256 + ch;
    float* RGP = WSP(float, O_RGP); float* RGH = WSP(float, O_RGH); const int cix = (d * NCHK + n) * 256 + ch;
    u32x4 gtr[4];
    if (OUT) { const bf16* PMg = WSP(bf16, O_PM) + (size_t)(r0 + (tid >> 5)) * PMC + 2304 + (tid & 31) * 8;
#pragma unroll
        for (int i = 0; i < 4; ++i) gtr[i] = *(const u32x4*)(PMg + (size_t)(16 * i) * PMC); }
    float h = OUT ? RGH[cix] : 0.f, lsum = 0.f;
    const int stp = d ? -256 : 256;
    for (int hb = 0; hb < 2; ++hb) { const int t0 = d ? 63 - 32 * hb : 32 * hb; bf16 lav[32], btv[32];
#pragma unroll
        for (int q = 0; q < 32; ++q) { lav[q] = LA[t0 * 256 + q * stp]; btv[q] = BT[t0 * 256 + q * stp]; }
#pragma unroll
        for (int q = 0; q < 32; ++q) { const float la = bf2f(lav[q]); h = __expf(la) * h + bf2f(btv[q]); lsum += la;
            if (OUT) { LAS float* yp = sY + t0 * 256 + q * stp + ch; if (hb == 0) *yp = h; else *yp += h; } }
        if (OUT) __syncthreads(); }
    if (!OUT) { RGP[cix] = __expf(lsum); RGH[cix] = h; }
    else { bf16* BR3 = WSP(bf16, O_BR) + (size_t)3 * TT * 256; const int c0 = (tid & 31) * 8;
#pragma unroll
        for (int i = 0; i < 4; ++i) { const int t = (tid >> 5) + 16 * i; const LAS f32x4* yp = (const LAS f32x4*)(sY + t * 256 + c0); const f32x4 y0 = yp[0], y1 = yp[1]; const u32x4 g = gtr[i];
            *(u32x4*)(BR3 + (size_t)(r0 + t) * 256 + c0) = (u32x4){pk2(y0[0] * gelu_tanh(bflo(g.x)), y0[1] * gelu_tanh(bfhi(g.x))), pk2(y0[2] * gelu_tanh(bflo(g.y)), y0[3] * gelu_tanh(bfhi(g.y))),
                                                                   pk2(y1[0] * gelu_tanh(bflo(g.z)), y1[1] * gelu_tanh(bfhi(g.z))), pk2(y1[2] * gelu_tanh(bflo(g.w)), y1[3] * gelu_tanh(bfhi(g.w)))}; }
        __syncthreads(); }
}
__device__ __forceinline__ void rg_carry(CArgs& A, int e) {
    const float* RGP = WSP(float, O_RGP); float* RGH = WSP(float, O_RGH);
    const int ch = e & 255, d = (e >> 8) & 1, b = e >> 9; float s = 0.f;
    for (int st = 0; st < 132; st += 22) { float tmp[22], pp[22]; int ix[22];
#pragma unroll
        for (int q = 0; q < 22; ++q) { ix[q] = (d * NCHK + seq_chunk(b, d, st + q)) * 256 + ch; tmp[q] = RGH[ix[q]]; pp[q] = RGP[ix[q]]; }
#pragma unroll
        for (int q = 0; q < 22; ++q) { RGH[ix[q]] = s; s = pp[q] * s + tmp[q]; } }
}
__device__ __forceinline__ void s5_carry(CArgs& A, int l, int e) {
    const int p = e & 63, d = (e >> 6) & 1, g = (e >> 7) & 15, b = e >> 11;
    const f32x2 w64 = WSP(f32x2, O_S5PW)[(size_t)(((l * 16 + g) * 2 + d) * 65 + 64) * 64 + p]; const float wr_ = w64.x, wi_ = w64.y;
    const float* HC = WSP(float, O_HC) + (size_t)g * 768 * 256; bf16* UH = WSP(bf16, O_UH) + (size_t)g * 768 * 1280;
    float sr = 0.f, si = 0.f;
    for (int st = 0; st < 132; st += 22) { float hr[22], hi[22]; int nn[22];
#pragma unroll
        for (int q = 0; q < 22; ++q) { nn[q] = seq_chunk(b, d, st + q); hr[q] = HC[(size_t)nn[q] * 256 + d * 128 + p]; hi[q] = HC[(size_t)nn[q] * 256 + d * 128 + 64 + p]; }
#pragma unroll
        for (int q = 0; q < 22; ++q) { UH[(size_t)nn[q] * 1280 + 1024 + d * 128 + p] = (bf16)f2bf(sr); UH[(size_t)nn[q] * 1280 + 1024 + d * 128 + 64 + p] = (bf16)f2bf(si);
            const float t = wr_ * sr - wi_ * si + hr[q]; si = wr_ * si + wi_ * sr + hi[q]; sr = t; } }
}

__device__ __forceinline__ void hy_pre_unit(CArgs& A, LAS unsigned char* lds, int l, int n) {
    const int tid = tidx(); LAS float* sZ = (LAS float*)lds; const bf16* PM = WSP(bf16, O_PM);
    const int r0 = n * 64; int s0, s1; seq_bounds(n, s0, s1); const int c0 = (tid & 31) * 8, tq = tid >> 5;
    float wv[3][8], w1[3][8];
#pragma unroll
    for (int k = 0; k < 3; ++k) { const float* wp = A.in[I_HWS] + (l * 3 + k) * 768 + c0; const f32x4 a = *(const f32x4*)wp, b = *(const f32x4*)(wp + 4), c = *(const f32x4*)(wp + 512), d = *(const f32x4*)(wp + 516);
        wv[k][0] = a[0]; wv[k][1] = a[1]; wv[k][2] = a[2]; wv[k][3] = a[3]; wv[k][4] = b[0]; wv[k][5] = b[1]; wv[k][6] = b[2]; wv[k][7] = b[3];
        w1[k][0] = c[0]; w1[k][1] = c[1]; w1[k][2] = c[2]; w1[k][3] = c[3]; w1[k][4] = d[0]; w1[k][5] = d[1]; w1[k][6] = d[2]; w1[k][7] = d[3]; }
    u32x4 xa[4][3], xb[4][3];
#pragma unroll
    for (int i = 0; i < 4; ++i)
#pragma unroll
        for (int k = 0; k < 3; ++k) { const int rr = r0 + tq + 16 * i + k - 1; const bool ok = rr >= s0 && rr < s1; const int rc = min(max(rr, s0), s1 - 1);
            const u32x4 a = *(const u32x4*)(PM + (size_t)rc * PMC + 1280 + c0), b = *(const u32x4*)(PM + (size_t)rc * PMC + 1792 + c0);
            xa[i][k] = ok ? a : (u32x4){0u, 0u, 0u, 0u}; xb[i][k] = ok ? b : (u32x4){0u, 0u, 0u, 0u}; }
#pragma unroll
    for (int i = 0; i < 4; ++i) { const int t = tq + 16 * i; float pv[8], p1[8];
#pragma unroll
        for (int e = 0; e < 8; ++e) { pv[e] = 0.f; p1[e] = 0.f; }
#pragma unroll
        for (int k = 0; k < 3; ++k) { const u32x4 a = xa[i][k], b = xb[i][k];
            pv[0] += wv[k][0] * bflo(a.x); pv[1] += wv[k][1] * bfhi(a.x); pv[2] += wv[k][2] * bflo(a.y); pv[3] += wv[k][3] * bfhi(a.y); pv[4] += wv[k][4] * bflo(a.z); pv[5] += wv[k][5] * bfhi(a.z); pv[6] += wv[k][6] * bflo(a.w); pv[7] += wv[k][7] * bfhi(a.w);
            p1[0] += w1[k][0] * bflo(b.x); p1[1] += w1[k][1] * bfhi(b.x); p1[2] += w1[k][2] * bflo(b.y); p1[3] += w1[k][3] * bfhi(b.y); p1[4] += w1[k][4] * bflo(b.z); p1[5] += w1[k][5] * bfhi(b.z); p1[6] += w1[k][6] * bflo(b.w); p1[7] += w1[k][7] * bfhi(b.w); }
        if (n < 512) {
#pragma unroll
            for (int e = 0; e < 8; ++e) sZ[(c0 + e) * 65 + t] = p1[e] * pv[e]; }
        else { float* zp = WSP(float, O_ZC) + (size_t)(r0 - TL + t) * 256 + c0;
            *(f32x4*)zp = (f32x4){p1[0] * pv[0], p1[1] * pv[1], p1[2] * pv[2], p1[3] * pv[3]}; *(f32x4*)(zp + 4) = (f32x4){p1[4] * pv[4], p1[5] * pv[5], p1[6] * pv[6], p1[7] * pv[7]}; } }
    if (n < 512) { __syncthreads(); const int b = n >> 7, t0 = (n & 127) * 64; float* ZT = WSP(float, O_ZT);
        for (int idx = tid; idx < 256 * 16; idx += NTHR) { const int cc = idx >> 4, seg = idx & 15; const LAS float* sp = sZ + cc * 65 + seg * 4;
            *(f32x4*)(ZT + ((size_t)(b * 256 + cc)) * 8192 + t0 + seg * 4) = (f32x4){sp[0], sp[1], sp[2], sp[3]}; } }
    __syncthreads();
}
__host__ __device__ constexpr float c32(int k) { constexpr float t[16] = {1.0f, 0.98078528040323f, 0.92387953251129f, 0.83146961230255f, 0.70710678118655f, 0.55557023301960f, 0.38268343236509f, 0.19509032201613f,
    0.0f, -0.19509032201613f, -0.38268343236509f, -0.55557023301960f, -0.70710678118655f, -0.83146961230255f, -0.92387953251129f, -0.98078528040323f}; return t[k]; }
__host__ __device__ constexpr float s32(int k) { constexpr float t[16] = {0.0f, 0.19509032201613f, 0.38268343236509f, 0.55557023301960f, 0.70710678118655f, 0.83146961230255f, 0.92387953251129f, 0.98078528040323f,
    1.0f, 0.98078528040323f, 0.92387953251129f, 0.83146961230255f, 0.70710678118655f, 0.55557023301960f, 0.38268343236509f, 0.19509032201613f}; return t[k]; }
__host__ __device__ constexpr int brev(int p, int L) { int r = 0; for (int i = 0; i < L; ++i) r |= ((p >> i) & 1) << (L - 1 - i); return r; }
template <int L, bool CONJ> __device__ __forceinline__ void dif_regs(f32x2 (&v)[1 << L]) {
    constexpr int n = 1 << L;
#pragma unroll
    for (int s = 0; s < L; ++s) {
#pragma unroll
        for (int i = 0; i < n / 2; ++i) { const int half = n >> (s + 1), grp = i / half, k = i % half, i0 = grp * 2 * half + k, i1 = i0 + half, tw = (k << s) * (32 / n);
            const f32x2 a = v[i0], b = v[i1]; v[i0] = a + b; const f32x2 d = a - b; const float c = c32(tw), sn = s32(tw);
            if (tw == 0) v[i1] = d;
            else v[i1] = CONJ ? (f32x2){d.x * c - d.y * sn, d.y * c + d.x * sn} : (f32x2){d.x * c + d.y * sn, d.y * c - d.x * sn}; } }
}
__device__ __forceinline__ int fphys(int i) { return i + (i >> 4) + ((i >> 9) << 4); }
template <bool CONJ> __device__ __forceinline__ f32x2 tw_mul(const f32x2 v, float r) {
    const float c = __builtin_amdgcn_cosf(r), sn = __builtin_amdgcn_sinf(r);
    return CONJ ? (f32x2){v.x * c - v.y * sn, v.y * c + v.x * sn} : (f32x2){v.x * c + v.y * sn, v.y * c - v.x * sn};
}
#define FFT_SB() __builtin_amdgcn_sched_barrier(0)
__device__ __forceinline__ void fft_fwd16k(f32x2 (&v)[32], LAS f32x2* X, const f32x2* TW, int tid) {
    dif_regs<5, false>(v);
    { LAS f32x2* XA = X + tid + (tid >> 4); float tf = (float)tid; asm volatile("" : "+v"(tf));
#pragma unroll
      for (int p = 0; p < 32; ++p) { const int k1 = brev(p, 5); XA[k1 * 560] = tw_mul<false>(v[p], tf * ((float)k1 * (1.0f / 16384.0f))); if ((p & 7) == 7) FFT_SB(); } }
    __syncthreads();
    { const int k1 = tid >> 4, m2 = tid & 15; LAS f32x2* XB = X + k1 * 560 + m2; float mf = (float)m2; asm volatile("" : "+v"(mf));
#pragma unroll
      for (int m1 = 0; m1 < 32; ++m1) v[m1] = XB[m1 * 17];
      FFT_SB();
      dif_regs<5, false>(v);
      FFT_SB();
#pragma unroll
      for (int p = 0; p < 32; ++p) { const int q1 = brev(p, 5); XB[q1 * 17] = tw_mul<false>(v[p], mf * ((float)q1 * (1.0f / 512.0f))); if ((p & 7) == 7) FFT_SB(); } }
    __syncthreads();
#pragma unroll
    for (int gi = 0; gi < 2; ++gi) { const int g = 2 * tid + gi; LAS f32x2* XC = X + g * 17 + ((g >> 5) << 4); f32x2 u[16];
#pragma unroll
        for (int m = 0; m < 16; ++m) u[m] = XC[m];
        dif_regs<4, false>(u);
#pragma unroll
        for (int m = 0; m < 16; ++m) v[gi * 16 + m] = u[m];
        FFT_SB(); }
}
__device__ __forceinline__ void fft_inv16k(f32x2 (&v)[32], LAS f32x2* X, const f32x2* TW, int tid) {
#pragma unroll
    for (int gi = 0; gi < 2; ++gi) { const int g = 2 * tid + gi; LAS f32x2* XC = X + g * 17 + ((g >> 5) << 4); f32x2 u[16];
#pragma unroll
        for (int q = 0; q < 16; ++q) u[q] = v[gi * 16 + brev(q, 4)];
        dif_regs<4, true>(u);
#pragma unroll
        for (int p = 0; p < 16; ++p) XC[brev(p, 4)] = u[p];
        FFT_SB(); }
    __syncthreads();
    { const int k1 = tid >> 4, m2 = tid & 15; LAS f32x2* XB = X + k1 * 560 + m2; float mf = (float)m2; asm volatile("" : "+v"(mf));
#pragma unroll
      for (int q1 = 0; q1 < 32; ++q1) { v[q1] = tw_mul<true>(XB[q1 * 17], mf * ((float)q1 * (1.0f / 512.0f))); if ((q1 & 7) == 7) FFT_SB(); }
      dif_regs<5, true>(v);
      FFT_SB();
#pragma unroll
      for (int p = 0; p < 32; ++p) XB[brev(p, 5) * 17] = v[p]; }
    __syncthreads();
    { LAS f32x2* XA = X + tid + (tid >> 4); float tf = (float)tid; asm volatile("" : "+v"(tf));
#pragma unroll
      for (int k1 = 0; k1 < 32; ++k1) { v[k1] = tw_mul<true>(XA[k1 * 560], tf * ((float)k1 * (1.0f / 16384.0f))); if ((k1 & 7) == 7) FFT_SB(); } }
    dif_regs<5, true>(v);
}
__device__ __forceinline__ void hy_fft_unit(CArgs& A, LAS unsigned char* lds, int l, int c) {
    const int tid = tidx(), lane = tid & 63, wave = tid >> 6; LAS f32x2* X = (LAS f32x2*)lds; LAS float* sN = (LAS float*)(lds + 143360);
    const f32x2* TW = WSP(f32x2, O_TW); const float* HF = WSP(float, O_HFIL) + (size_t)l * 512 * 8192; const float* HPS = WSP(float, O_HPS) + (size_t)l * 512 * 128;
    const float* hf = HF + (size_t)c * 8192; const float* hb = HF + (size_t)(c + 256) * 8192;
    f32x2 v[32]; float hb0 = 0.f;
    { const unsigned ut = (unsigned)tid;
#pragma unroll
      for (int n1 = 0; n1 < 16; ++n1) v[n1] = (f32x2){(hf + n1 * 512)[ut], 0.f};
      if (tid == 0) hb0 = hb[0];
#pragma unroll
      for (int n1 = 16; n1 < 32; ++n1) { const float hv = (n1 == 16 && tid == 0) ? 0.f : (hb + 16384 - n1 * 512)[-(int)ut]; v[n1] = (f32x2){hv, 0.f}; } }
    if (wave < 2) { const float* p = HPS + (size_t)(c + 256 * wave) * 128; const float s = wave_sum(p[lane] + p[lane + 64]); if (lane == 0) sN[wave] = 1.0f / (s + EPS); }
    __syncthreads();
    { const float nf = sN[0], nb = sN[1];
#pragma unroll
      for (int n1 = 0; n1 < 16; ++n1) v[n1].x *= nf;
      v[0].x += hb0 * nb;
#pragma unroll
      for (int n1 = 16; n1 < 32; ++n1) v[n1].x *= nb; }
    fft_fwd16k(v, X, TW, tid);
    f32x2* GS = WSP(f32x2, O_GS) + (size_t)bidx() * 16384;
    { const unsigned ut = (unsigned)tidx();
#pragma unroll
      for (int i = 0; i < 32; ++i) (GS + i * 512)[ut] = v[i]; }
    const float* ZT = WSP(float, O_ZT); float* CZ = WSP(float, O_CZT); const float bias = A.in[I_HBIAS][l * 256 + c];
    for (int pr = 0; pr < 2; ++pr) {
        const float* z0 = ZT + ((size_t)((2 * pr) * 256 + c)) * 8192; const float* z1 = ZT + ((size_t)((2 * pr + 1) * 256 + c)) * 8192;
        float* c0 = CZ + ((size_t)((2 * pr) * 256 + c)) * 8192; float* c1 = CZ + ((size_t)((2 * pr + 1) * 256 + c)) * 8192;
        __syncthreads();
        { const unsigned ut = (unsigned)tidx();
#pragma unroll
          for (int n1 = 0; n1 < 16; ++n1) { v[n1] = (f32x2){(z0 + n1 * 512)[ut], (z1 + n1 * 512)[ut]}; v[n1 + 16] = (f32x2){0.f, 0.f}; } }
        fft_fwd16k(v, X, TW, tid);
        { const unsigned ut = (unsigned)tidx();
#pragma unroll
          for (int i = 0; i < 32; ++i) { const f32x2 x = v[i]; const unsigned long long gw = __hip_atomic_load((const unsigned long long*)((GS + i * 512) + ut), __ATOMIC_RELAXED, __HIP_MEMORY_SCOPE_AGENT);
            const float gx = __uint_as_float((unsigned)gw), gy = __uint_as_float((unsigned)(gw >> 32)); v[i] = (f32x2){x.x * gx - x.y * gy, x.x * gy + x.y * gx}; if ((i & 7) == 7) FFT_SB(); } }
        fft_inv16k(v, X, TW, tid);
        { const unsigned ut = (unsigned)tidx(); float zr0[16], zr1[16];
#pragma unroll
          for (int n1 = 0; n1 < 16; ++n1) { zr0[n1] = (z0 + n1 * 512)[ut]; zr1[n1] = (z1 + n1 * 512)[ut]; }
#pragma unroll
          for (int p = 0; p < 32; ++p) { const int n1 = brev(p, 5); if (n1 < 16) {
            (c0 + n1 * 512)[ut] = v[p].x * (1.0f / 16384.0f) + zr0[n1] * bias; (c1 + n1 * 512)[ut] = v[p].y * (1.0f / 16384.0f) + zr1[n1] * bias; } } }
    }
    __syncthreads();
}
__device__ __forceinline__ void hy_ctx_conv_half(CArgs& A, LAS unsigned char* lds, int l, int u, int hsel) {
    const int tid = tidx(), b = u >> 3, c0 = (u & 7) * 32 + hsel * 16;
    constexpr int HP = 545;
    LAS float* sZ = (LAS float*)lds; LAS float* sH = sZ + 256 * 17; LAS float* sN = sH + 16 * HP;
    const float* ZC = WSP(float, O_ZC) + (size_t)b * 256 * 256; const float* HF = WSP(float, O_HFILC); const float* PS = WSP(float, O_HPSC);
    if (tid < 32) { const int ch = (tid < 16 ? 0 : 256) + c0 + (tid & 15); sN[tid] = 1.0f / (PS[ch * 4] + PS[ch * 4 + 1] + PS[ch * 4 + 2] + PS[ch * 4 + 3] + EPS); }
    for (int idx = tid; idx < 4096; idx += NTHR) { const int s = idx >> 4, cc = idx & 15; sZ[s * 17 + cc] = ZC[(size_t)s * 256 + c0 + cc]; }
    __syncthreads();
    for (int idx = tid; idx < 16 * 528; idx += NTHR) { const int cc = idx / 528, k = idx - cc * 528, d = k - 264; float v = 0.f;
        if (d >= 0 && d <= 255) v += HF[(size_t)(c0 + cc) * 256 + d] * sN[cc];
        if (d <= 0 && d >= -255) v += HF[(size_t)(256 + c0 + cc) * 256 - d] * sN[16 + cc];
        sH[cc * HP + k] = v; }
    __syncthreads();
    const int cc = tid & 15, t0 = (tid >> 4) * 8; float acc[8];
#pragma unroll
    for (int j = 0; j < 8; ++j) acc[j] = 0.f;
    const LAS float* hp = sH + cc * HP + 264 + t0 - 7; const LAS float* zp = sZ + cc;
    for (int sb = 0; sb < 32; ++sb) { float f[15], z[8];
#pragma unroll
        for (int k = 0; k < 15; ++k) f[k] = hp[k - 8 * sb];
#pragma unroll
        for (int q = 0; q < 8; ++q) z[q] = zp[(8 * sb + q) * 17];
#pragma unroll
        for (int j = 0; j < 8; ++j)
#pragma unroll
            for (int q = 0; q < 8; ++q) acc[j] += f[j - q + 7] * z[q]; }
    float* CZ = WSP(float, O_CZC) + (size_t)b * 256 * 256; const float bias = A.in[I_HBIAS][l * 256 + c0 + cc];
#pragma unroll
    for (int j = 0; j < 8; ++j) CZ[(size_t)(t0 + j) * 256 + c0 + cc] = acc[j] + zp[(t0 + j) * 17] * bias;
    __syncthreads();
}
__device__ __forceinline__ void hy_ctx_conv_unit(CArgs& A, LAS unsigned char* lds, int l, int u, int hsel) {
    if (hsel < 0) { hy_ctx_conv_half(A, lds, l, u, 0); hy_ctx_conv_half(A, lds, l, u, 1); } else hy_ctx_conv_half(A, lds, l, u, hsel);
}
__device__ __forceinline__ void hy_out_unit(CArgs& A, LAS unsigned char* lds, int l, int n) {
    const int tid = tidx(); LAS float* sZ = (LAS float*)lds; const bf16* PM = WSP(bf16, O_PM);
    const int r0 = n * 64; int s0, s1; seq_bounds(n, s0, s1); const int c = tid & 255, half = tid >> 8, tb = half * 32;
    float w0[3]; bf16 xr[34];
#pragma unroll
    for (int k = 0; k < 3; ++k) w0[k] = A.in[I_HWS][(l * 3 + k) * 768 + 256 + c];
#pragma unroll
    for (int q = 0; q < 34; ++q) { const int rr = r0 + tb + q - 1; const int rc = min(max(rr, s0), s1 - 1); xr[q] = PM[(size_t)rc * PMC + 1536 + c]; }
    if (n < 512) { const int b = n >> 7, t0 = (n & 127) * 64; const float* ZT = WSP(float, O_CZT);
        for (int idx = tid; idx < 256 * 16; idx += NTHR) { const int cc = idx >> 4, seg = idx & 15; const f32x4 v = *(const f32x4*)(ZT + ((size_t)(b * 256 + cc)) * 8192 + t0 + seg * 4); LAS float* s = sZ + cc * 65 + seg * 4; s[0] = v[0]; s[1] = v[1]; s[2] = v[2]; s[3] = v[3]; }
        __syncthreads(); }
    bf16* BR2 = WSP(bf16, O_BR) + (size_t)2 * TT * 256;
    { float xv[34], czv[32];
#pragma unroll
        for (int q = 0; q < 34; ++q) { const int rr = r0 + tb + q - 1; xv[q] = (rr >= s0 && rr < s1) ? bf2f(xr[q]) : 0.f; }
#pragma unroll
        for (int q = 0; q < 32; ++q) czv[q] = n < 512 ? sZ[c * 65 + tb + q] : WSP(float, O_CZC)[(size_t)(r0 - TL + tb + q) * 256 + c];
#pragma unroll
        for (int q = 0; q < 32; ++q) BR2[(size_t)(r0 + tb + q) * 256 + c] = (bf16)f2bf((w0[0] * xv[q] + w0[1] * xv[q + 1] + w0[2] * xv[q + 2]) * czv[q]); }
    __syncthreads();
}

struct ConvItem { const float* src; unsigned char* dst; int N, ldk; };
__device__ __forceinline__ ConvItem moe_conv_item(CArgs& A, int it, int lane) {
    constexpr int I_G = 16 * 112, I_D = 56 * 16; const int e = it / (I_G + I_D); int r = it % (I_G + I_D); ConvItem c;
    if (r < I_G) { const int kb = r / 112, nb = r % 112; c.N = 2 * DEX; c.ldk = DM; c.src = A.in[I_MGU] + (size_t)e * DM * 2 * DEX + (size_t)(kb * 64 + (lane >> 4)) * c.N + nb * 64 + 4 * (lane & 15);
        c.dst = WSP(unsigned char, O_MWGU) + (size_t)e * 2 * DEX * DM + (size_t)swiglu_dest(nb * 64, DEX) * DM + kb * 64; }
    else { r -= I_G; const int kb = r / 16, nb = r % 16; c.N = DM; c.ldk = DEX; c.src = A.in[I_MDN] + (size_t)e * DEX * DM + (size_t)(kb * 64 + (lane >> 4)) * c.N + nb * 64 + 4 * (lane & 15);
        c.dst = WSP(unsigned char, O_MWDN) + (size_t)e * DM * DEX + (size_t)(nb * 64) * DEX + kb * 64; }
    return c;
}
__device__ __forceinline__ void moe_convert_weights(CArgs& A, LAS unsigned char* lds) {
    const int tid = tidx(), lane = tid & 63, wave = tid >> 6; const int gw = bidx() * NWAVE + wave, NGW = gdim() * NWAVE;
    LAS float* scr = (LAS float*)(lds + wave * 17408);
    constexpr int NITEM = NEX * (16 * 112 + 56 * 16);
    f32x4 v[16], vn[16]; ConvItem cur, nxt;
    int it = gw; if (it >= NITEM) return;
    cur = moe_conv_item(A, it, lane);
#pragma unroll
    for (int i = 0; i < 16; ++i) v[i] = __builtin_nontemporal_load((const f32x4*)(cur.src + (size_t)(4 * i) * cur.N));
    for (;;) {
        const int itn = it + NGW; const bool more = itn < NITEM;
        if (more) { nxt = moe_conv_item(A, itn, lane);
#pragma unroll
            for (int i = 0; i < 16; ++i) vn[i] = __builtin_nontemporal_load((const f32x4*)(nxt.src + (size_t)(4 * i) * nxt.N)); }
#pragma unroll
        for (int i = 0; i < 16; ++i) { LAS float* d = scr + (4 * i + (lane >> 4)) * 65 + 4 * (lane & 15); d[0] = v[i][0]; d[1] = v[i][1]; d[2] = v[i][2]; d[3] = v[i][3]; }
        asm volatile("s_waitcnt lgkmcnt(0)" ::: "memory");
        { const int kg = lane & 3;
#pragma unroll
          for (int q = 0; q < 4; ++q) { const int n = (lane >> 2) + 16 * q; const LAS float* s = scr + (16 * kg) * 65 + n;
            u32x4 o; o.x = pack4_fp8(32.f * s[0], 32.f * s[65], 32.f * s[130], 32.f * s[195]); o.y = pack4_fp8(32.f * s[260], 32.f * s[325], 32.f * s[390], 32.f * s[455]);
            o.z = pack4_fp8(32.f * s[520], 32.f * s[585], 32.f * s[650], 32.f * s[715]); o.w = pack4_fp8(32.f * s[780], 32.f * s[845], 32.f * s[910], 32.f * s[975]);
            *(u32x4*)(cur.dst + (size_t)n * cur.ldk + 16 * kg) = o; } }
        asm volatile("s_waitcnt lgkmcnt(0)" ::: "memory");
        if (!more) break;
        it = itn; cur = nxt;
#pragma unroll
        for (int i = 0; i < 16; ++i) v[i] = vn[i];
    }
}
#ifndef CONV_PROBE
#define CONV_PROBE 0
#endif
__device__ __forceinline__ void moe_convert_loads_only(CArgs& A) {
    const int tid = tidx(), lane = tid & 63, wave = tid >> 6; const int gw = bidx() * NWAVE + wave, NGW = gdim() * NWAVE;
    constexpr int I_G = 16 * 112, I_D = 56 * 16;
    for (int it = gw; it < NEX * (I_G + I_D); it += NGW) { const int e = it / (I_G + I_D); int r = it % (I_G + I_D); const float* W; int N, k0, n0;
        if (r < I_G) { W = A.in[I_MGU] + (size_t)e * DM * 2 * DEX; N = 2 * DEX; k0 = (r / 112) * 64; n0 = (r % 112) * 64; } else { r -= I_G; W = A.in[I_MDN] + (size_t)e * DEX * DM; N = DM; k0 = (r / 16) * 64; n0 = (r % 16) * 64; }
        const int tiles_n = N / 256; const int q = r; const int kb16 = q / tiles_n, nb256 = q % tiles_n; (void)k0; (void)n0;
        const float* src = W + (size_t)(kb16 * 16) * N + nb256 * 256 + 4 * lane; f32x4 v[16];
#pragma unroll
        for (int i = 0; i < 16; ++i) v[i] = __builtin_nontemporal_load((const f32x4*)(src + (size_t)i * N));
#pragma unroll
        for (int i = 0; i < 16; ++i) asm volatile("" :: "v"(v[i])); }
}
__device__ __forceinline__ void moe_bases(const unsigned* ctl, int s, int (&tb)[9]) {
    int acc = 0;
#pragma unroll
    for (int e = 0; e < 8; ++e) { tb[e] = acc; const unsigned c = __hip_atomic_load(ctl + CW_CNT + s * 8 + e, __ATOMIC_RELAXED, __HIP_MEMORY_SCOPE_AGENT); acc += (int)((c + 255u) >> 8); }
    tb[8] = acc;
}
__device__ __forceinline__ void ph_moe_scatter(CArgs& A, LAS unsigned char* lds) {
    const int tid = tidx(), lane = tid & 63, wave = tid >> 6, G = gdim(), bx = bidx(); const int tpb = TL / G;
    unsigned* ctl = WSP(unsigned, O_CTL);
    LAS unsigned* sB = (LAS unsigned*)lds;
    LAS unsigned* sTot = sB + 4096; LAS unsigned* sRun = sTot + 16; LAS unsigned* sBase = sRun + 16;
    for (int i = tid; i < G * 16; i += NTHR) sB[i] = __hip_atomic_load(ctl + CW_BLK + i, __ATOMIC_RELAXED, __HIP_MEMORY_SCOPE_AGENT);
    __syncthreads();
    if (tid < 16) { unsigned tot = 0, pre = 0; for (int b = 0; b < G; ++b) { const unsigned c = sB[b * 16 + tid]; tot += c; pre += (b < bx) ? c : 0u; } sTot[tid] = tot; sRun[tid] = pre; }
    __syncthreads();
    if (tid < 2) { unsigned acc = 0; for (int e = 0; e < 8; ++e) { sBase[tid * 8 + e] = acc * 256u; acc += (sTot[tid * 8 + e] + 255u) >> 8; } }
    __syncthreads();
    if (tid < 16) { sRun[tid] += sBase[tid]; if (bx == 0) ctl[CW_CNT + tid] = sTot[tid]; }
    __syncthreads();
    int* RT = WSP(int, O_RTOK); float* RW = WSP(float, O_RW); const bf16* H = WSP(bf16, O_H); bf16* H2S = WSP(bf16, O_H2S);
    if (bx == 0) {
        for (int j = 0; j < 16; ++j) { const int s = j >> 3, base = (int)sBase[j], cnt = (int)sTot[j], end = base + (int)(((sTot[j] + 255u) >> 8) << 8);
            for (int i = base + cnt + tid; i < end; i += NTHR) RT[s * MOE_ROWS + i] = -1; } }
    for (int it = 0; it * NWAVE < tpb; ++it) { const int t = bx * tpb + wave + it * NWAVE;
        const u32x4 ti = WSP(u32x4, O_TOKI)[t];
        int p0 = 0, p1 = 0;
        if (lane == 0) { p0 = (int)__hip_atomic_fetch_add(sRun + ti.x, 1u, __ATOMIC_RELAXED, __HIP_MEMORY_SCOPE_WORKGROUP); p1 = (int)__hip_atomic_fetch_add(sRun + 8 + ti.y, 1u, __ATOMIC_RELAXED, __HIP_MEMORY_SCOPE_WORKGROUP);
            RT[p0] = t; RW[p0] = __uint_as_float(ti.z); RT[MOE_ROWS + p1] = t; RW[MOE_ROWS + p1] = __uint_as_float(ti.w); WSP(u32x2, O_TPOS)[t] = (u32x2){(unsigned)p0, (unsigned)(MOE_ROWS + p1)}; }
        p0 = __shfl(p0, 0); p1 = __shfl(p1, 0);
        const u32x4 a = ((const u32x4*)((const unsigned char*)H + (size_t)t * DM))[lane];
        ((u32x4*)((unsigned char*)H2S + (size_t)p0 * DM))[lane] = a; ((u32x4*)((unsigned char*)H2S + ((size_t)MOE_ROWS + p1) * DM))[lane] = a;
    }
    __syncthreads();
}
__device__ __forceinline__ void ph_final(CArgs& A) {
    const int lane = tidx() & 63, wave = tidx() >> 6; const int gw = bidx() * NWAVE + wave, NGW = gdim() * NWAVE;
    const bf16* DL = WSP(bf16, O_H2S); const u32x2* TP = WSP(u32x2, O_TPOS); const bf16* XB = WSP(bf16, O_XB);
    f32x4 fg[4];
#pragma unroll
    for (int j = 0; j < 4; ++j) fg[j] = ((const f32x4*)A.in[I_FING])[lane + 64 * j];
#define FIN_LD(s_, k_) do { const int r_ = rb + (k_) * NGW; const unsigned t0_ = (unsigned)__shfl((int)tpl.x, (k_)), t1_ = (unsigned)__shfl((int)tpl.y, (k_)); \
        const u32x2* xr_ = (const u32x2*)(XB + (size_t)r_ * DM); const u32x2* d0_ = (const u32x2*)(DL + (size_t)t0_ * DM); const u32x2* d1_ = (const u32x2*)(DL + (size_t)t1_ * DM); \
        _Pragma("unroll") for (int j = 0; j < 4; ++j) { raw[s_][j] = xr_[lane + 64 * j]; raw[s_][4 + j] = d0_[lane + 64 * j]; raw[s_][8 + j] = d1_[lane + 64 * j]; } } while (0)
#define FIN_DO(s_, k_) do { const int r_ = rb + (k_) * NGW; f32x4* p_ = (f32x4*)(A.out + (size_t)r_ * DM); f32x4 v[4]; float ss = 0.f; \
        _Pragma("unroll") for (int j = 0; j < 4; ++j) { const u32x2 xw = raw[s_][j], a = raw[s_][4 + j], b = raw[s_][8 + j]; \
            v[j] = (f32x4){bflo(xw.x) + (bflo(a.x) + bflo(b.x)), bfhi(xw.x) + (bfhi(a.x) + bfhi(b.x)), bflo(xw.y) + (bflo(a.y) + bflo(b.y)), bfhi(xw.y) + (bfhi(a.y) + bfhi(b.y))}; \
            ss += (v[j][0] * v[j][0] + v[j][1] * v[j][1]) + (v[j][2] * v[j][2] + v[j][3] * v[j][3]); } \
        const float rstd = 1.0f / sqrtf(wave_sum(ss) * (1.0f / DM) + EPS); \
        _Pragma("unroll") for (int j = 0; j < 4; ++j) p_[lane + 64 * j] = v[j] * rstd * fg[j]; } while (0)
    for (int rb = gw; rb < TL; rb += 64 * NGW) {
        u32x2 tpl = (u32x2){0u, 0u}; { const int rl = rb + lane * NGW; if (rl < TL) tpl = TP[rl]; }
        int nr = (TL - rb + NGW - 1) / NGW; if (nr > 64) nr = 64;
        u32x2 raw[2][12];
        FIN_LD(0, 0);
        for (int k = 0; k < nr; k += 2) {
            if (k + 1 < nr) FIN_LD(1, k + 1);
            FIN_DO(0, k);
            if (k + 1 < nr) { if (k + 2 < nr) FIN_LD(0, k + 2); FIN_DO(1, k + 1); }
        }
    }
#undef FIN_LD
#undef FIN_DO
}

#ifndef PHMASK
#define PHMASK 0xFFFFFFFFu
#endif
#define EN(j) ((PHMASK >> (j)) & 1u)
#ifndef UMASK
#define UMASK 0xFu
#endif
#define UEN(j) ((UMASK >> (j)) & 1u)
#define IN(k) (lo <= (k) && (k) < hi)
#ifndef DUPBAR
#define DUPBAR 0
#endif
#define SEAM(k) do { if (IN(k) && IN((k) + 1)) { xcd_barrier(bar); if (DUPBAR) xcd_barrier(bar); } } while (0)
#ifndef DUPMASK
#define DUPMASK 0u
#endif
#define DUP(j) for (int _r = 0; _r < (((DUPMASK >> (j)) & 1u) ? 2 : 1); ++_r)
#ifndef F8_SP2
#define F8_SP2 true
#endif
#define PH_LOCALS CArgs& A = KA; const int G = gdim(), bx = bidx(); (void)G; (void)bx
template <int l>
__device__ __forceinline__ void layer_body(LAS unsigned char* lds, const XcdBarrier& bar, int lo, int hi) {
    constexpr int P = 1 + 12 * l;
    if (EN(0) && IN(P + 0)) { { PH_LOCALS; for (int u = bx; u < 256; u += G) s5_fill_unit(A, l, u); } { PH_LOCALS; DUP(6) ph_norm(A, lds, l, 0, l == 0, false); } }
    SEAM(P + 0);
    if (EN(1) && IN(P + 1)) {
        PH_LOCALS;
        pg8::Gemm g{WSP(bf16, O_H), WSP(bf16, O_WIN) + (size_t)l * NINP * DM, DM, DM, DM}; pg8::StaticOrder S; S.init(NRT, NINP / 256, G, bx);
        EpiInProj E{WSP(bf16, O_PM), WSP(unsigned char, O_SG), WSP(bf16, O_GDN), WSP(bf16, O_UH)};
        DUP(14) pg8::gemm_phase(lds, g, S, E);
    }
    SEAM(P + 1);
    if (EN(2) && IN(P + 2)) {
        { PH_LOCALS; pg8::Gemm g{WSP(bf16, O_UH), WSP(bf16, O_BPOW), 1280, 1024, 1024}; OneUnit S; S.has = bx < 48; S.u.pa = bx; S.u.pb = bx / 3; S.u.pm = bx % 3; S.u.pn = 0; S.u.aux = bx / 3;
          EpiF32 E{WSP(float, O_HC), 256}; pg8::gemm_phase(lds, g, S, E); }
        { PH_LOCALS; constexpr int nhy = l == 0 ? NCHK : 512, NU = 2112 + NCHK + nhy;
          constexpr int NXA = 5;
          const int nA = (G > 48 && bx >= 48) ? NXA : 0, poolA = G > 48 ? NXA * (G - 48) : 0;
          for (int i = 0;; ++i) { const int u = i < nA ? (bx - 48) * NXA + i : poolA + bx + (i - nA) * G; if (u >= NU) break;
            if (u < 2112) { DUP(2) gla_local_unit(A, lds, l, u >> 2, u & 3); }
            else if (u < 2112 + NCHK) { DUP(3) rg_conv_unit(A, l, u - 2112); }
            else hy_pre_unit(A, lds, l, u - 2112 - NCHK);
          } }
    }
    SEAM(P + 2);
    if (EN(3) && IN(P + 3)) {
        { PH_LOCALS; for (int u = bx; u < 256; u += G) hy_fft_unit(A, lds, l, u); }
        { PH_LOCALS; pg8::Gemm g{WSP(bf16, O_XC), WSP(bf16, O_WRG) + (size_t)l * 1024 * 256, 256, 256, 256}; pg8::StaticOrder S; S.init(NRT, 4, G, bx);
          EpiRG E{WSP(bf16, O_XC), WSP(bf16, O_RLA), WSP(bf16, O_RBT), A.in[I_RBA] + l * 512, A.in[I_RBX] + l * 512, WSP(float, O_RGSP) + l * 512}; pg8::gemm_phase(lds, g, S, E); }
        { PH_LOCALS; gla_carry(A); }
        { PH_LOCALS; const int e = (G - 1 - bx) * NTHR + tidx(); if (e < 8192) s5_carry(A, l, e); }
    }
    SEAM(P + 3);
    if (EN(4) && IN(P + 4)) {
        { PH_LOCALS; pg8::Gemm g{WSP(bf16, O_UH), WSP(bf16, O_TCM), 1280, 1280, 1280}; OneUnit S; constexpr bool LASTL = l == 1; const bool noctx = LASTL && G == 256;
          S.has = bx < (noctx ? 128 : 192); const int gg = noctx ? bx >> 3 : bx / 12, pm = noctx ? (bx >> 2) & 1 : (bx % 12) >> 2, pn = bx & 3;
          S.u.pa = gg * 3 + pm; S.u.pb = gg * 4 + pn; S.u.pm = pm; S.u.pn = pn; S.u.aux = gg;
          EpiS5Y E{WSP(bf16, O_GBUF)}; pg8::gemm_phase(lds, g, S, E); }
        { PH_LOCALS; const bool ctxh = l == 0 && G == 256;
          if (ctxh && bx >= 192) hy_ctx_conv_unit(A, lds, l, (bx - 192) >> 1, (bx - 192) & 1);
          const bool noctx = l == 1 && G == 256; const int NGO = noctx ? 2048 : 2112, NB = noctx ? 128 : 192;
          const int NU = NGO + NCHK + ((l == 0 && !ctxh) ? 32 : 0);
          const int nX = ctxh ? 2 : 3;
          const int nA = (G > NB && bx >= NB) ? nX : 0, poolA = G > NB ? nX * (G - NB) : 0;
          for (int i = 0;; ++i) { const int u = i < nA ? (bx - NB) * nX + i : poolA + bx + (i - nA) * G; if (u >= NU) break;
            if (u < NGO) { DUP(2) gla_out_unit(A, lds, l, u >> 2, u & 3); }
            else if (u < NGO + NCHK) { DUP(3) rg_scan_unit<false>(A, lds, l, u - NGO); }
            else hy_ctx_conv_unit(A, lds, l, u - NGO - NCHK, -1);
          } }
    }
    SEAM(P + 4);
    if (EN(5) && IN(P + 5)) {
        { PH_LOCALS; const int rb = G >= 256 ? G - 133 - bx : G - 1 - bx; const int e = rb * NTHR + tidx(); if (rb >= 0 && e < 2048) rg_carry(A, e); }
        { PH_LOCALS; pg8::Gemm g{WSP(bf16, O_GBUF), WSP(bf16, O_WGLU) + (size_t)l * 65536, 256, 256, 256}; pg8::StaticOrder S; S.init((l == 1 && G == 256) ? 128 : NRT, 1, G, G >= 256 ? (bx + 132) % G : bx);
          EpiGlu E{WSP(bf16, O_GBUF), WSP(bf16, O_BR) + (size_t)TT * 256, A.in[I_BGLU] + l * 256}; pg8::gemm_phase(lds, g, S, E); }
        { PH_LOCALS; constexpr int NU = l == 0 ? NCHK : 512;
          for (int u = bx; u < NU; u += G) hy_out_unit(A, lds, l, u); }
    }
    SEAM(P + 5);
    if (EN(6) && IN(P + 6)) { PH_LOCALS; for (int u = bx; u < ((l == 1 && G == 256) ? 512 : NCHK); u += G) { DUP(3) rg_scan_unit<true>(A, lds, l, u); } }
    SEAM(P + 6);
    if (EN(7) && IN(P + 7)) {
        PH_LOCALS; constexpr int NU = (l == 0 ? TT : TL) / 128 * 4;
        const int vb = (G % 8 == 0) ? (bx % 8) * (G / 8) + bx / 8 : bx;
        for (int u = vb; u < NU; u += G) DUP(1) merge_unit(A, lds, l, u >> 2, u & 3);
    }
    SEAM(P + 7);
    if (EN(8) && IN(P + 8)) {
        PH_LOCALS;
        pg8::Gemm g{WSP(bf16, O_H), WSP(bf16, O_WOUT) + (size_t)l * 1024 * 1024, DM, DM, DM}; SplitOrder S; S.G = G; S.c = (G % 8 == 0) ? (bx % 8) * (G / 8) + bx / 8 : bx; S.U = (l == 0 ? NRT : TL / 256) * 4; S.KT = DM / 64; S.pa0 = 0; S.moe = 0; S.smax = 1;
        EpiResid E{WSP(bf16, O_XB), WSP(float, O_MODS) + (size_t)l * 5 * 6144 + 2 * 1024, 1.0f}; pg8::gemm_phase(lds, g, S, E);
#if (DUPMASK >> 11) & 1
        { EpiResid E0 = E; E0.sc = 0.f; pg8::gemm_phase(lds, g, S, E0); }
#endif

    }
    SEAM(P + 8);
    if (EN(9) && IN(P + 9)) { if (l == 1) { PH_LOCALS; moe_convert_weights(A, lds); }
#if (DUPMASK >> 10) & 1
        { PH_LOCALS; moe_convert_weights(A, lds); }
#endif
#if CONV_PROBE
        { PH_LOCALS; moe_convert_loads_only(A); }
#endif
        { PH_LOCALS; if (l == 0) { DUP(6) ph_norm(A, lds, l, 1, false, false); } else ph_norm(A, lds, l, 1, false, true); } }
    SEAM(P + 9);
    if constexpr (l == 0) {
        if (EN(10) && IN(P + 10)) { PH_LOCALS; pg8::Gemm g{WSP(bf16, O_H), WSP(bf16, O_WGU), DM / 2, DM / 2, DM / 2}; pg8::StaticOrder S; S.init(NRT, 2 * DFF / 256, G, bx);
            EpiSwiGLU8 E{WSP(unsigned char, O_FMID), DFF}; DUP(0) pg8::gemm_phase<EpiSwiGLU8, pg8::StaticOrder, true, true, F8_SP2>(lds, g, S, E); }
        SEAM(P + 10);
        if (EN(11) && IN(P + 11)) { PH_LOCALS; pg8::Gemm g{WSP(bf16, O_FMID), WSP(bf16, O_WDN), DFF / 2, DFF / 2, DFF / 2}; SplitOrder S; S.G = G; S.c = (G % 8 == 0) ? (bx % 8) * (G / 8) + bx / 8 : bx; S.U = NRT * 4; S.KT = DFF / 128; S.pa0 = 0; S.moe = 0; S.smax = 1;
            EpiResid E{WSP(bf16, O_XB), WSP(float, O_MODS) + (size_t)l * 5 * 6144 + 5 * 1024, 1.0f / 128.0f}; pg8::gemm_phase<EpiResid, SplitOrder, true, true, F8_SP2>(lds, g, S, E);
#if (DUPMASK >> 12) & 1
            { EpiResid E0 = E; E0.sc = 0.f; pg8::gemm_phase<EpiResid, SplitOrder, true, true, F8_SP2>(lds, g, S, E0); }
#endif
            }
        SEAM(P + 11);
    } else {
        if (EN(12) && IN(P + 10)) { PH_LOCALS; ph_moe_scatter(A, lds); }
        SEAM(P + 10);
        if (EN(13) && IN(P + 11)) { PH_LOCALS; Moe2Order S; S.G = G; S.c = bx; S.nN = 2 * DEX / 256; moe_bases(WSP(unsigned, O_CTL), 0, S.tb0); moe_bases(WSP(unsigned, O_CTL), 1, S.tb1);
            pg8::Gemm g{WSP(bf16, O_H2S), WSP(bf16, O_MWGU), DM / 2, DM / 2, DM / 2}; EpiSwiGLU8 E{WSP(unsigned char, O_MMID), DEX}; pg8::gemm_phase<EpiSwiGLU8, Moe2Order, true, true, F8_SP2>(lds, g, S, E); }
        SEAM(P + 11);
        if (EN(14) && IN(P + 12)) { PH_LOCALS; Moe2Order S; S.G = G; S.c = (G % 8 == 0) ? (bx % 8) * (G / 8) + bx / 8 : bx; S.nN = 4; moe_bases(WSP(unsigned, O_CTL), 0, S.tb0); moe_bases(WSP(unsigned, O_CTL), 1, S.tb1);
            pg8::Gemm g{WSP(bf16, O_MMID), WSP(bf16, O_MWDN), DEX / 2, DEX / 2, DEX / 2};
            EpiMoeDelta E{WSP(bf16, O_H2S), WSP(float, O_MODS) + (size_t)l * 5 * 6144 + 5 * 1024, WSP(int, O_RTOK), WSP(float, O_RW), 1.0f / 128.0f}; pg8::gemm_phase<EpiMoeDelta, Moe2Order, true, true, F8_SP2>(lds, g, S, E); }
        SEAM(P + 12);
    }
}
constexpr int N_PHASES = 27;
__global__ void __launch_bounds__(NTHR, 2) fwd_kernel(Args A_unused) {
    extern __shared__ __attribute__((aligned(16))) unsigned char lds_raw[];
    LAS unsigned char* lds = (LAS unsigned char*)lds_raw;
    volatile LAS unsigned* MISC = (volatile LAS unsigned*)(lds + LDS_MISC);
    if (tidx() < 16) MISC[tidx()] = 0u;
    __syncthreads();
    int lo, hi; XcdBarrier bar;
    { CArgs& A = KA; lo = A.ph_lo; hi = A.ph_hi; unsigned* ctl = WSP(unsigned, O_CTL);
      bar.bar = ctl + CW_BAR; bar.x = 0; bar.st = MISC + 8;
      if (hi - lo > 1) bar = xcd_barrier_post(ctl + CW_BAR, MISC + 8); }
    if (EN(16) && IN(0)) { { PH_LOCALS; ph_prologue(A, lds); }
#if (DUPMASK >> 9) & 1
        __syncthreads(); { PH_LOCALS; ph_prologue(A, lds); }
#endif
    }
    SEAM(0);
    layer_body<0>(lds, bar, lo, hi);
    layer_body<1>(lds, bar, lo, hi);
    if (EN(17) && IN(26)) { PH_LOCALS; ph_final(A); }
}

#ifndef MK_PER_PHASE
#define MK_PER_PHASE 0
#endif
extern "C" void kernel_launch(void* const* d_in, const int* in_sizes, int n_in, void* d_out, int out_size, void* d_ws, size_t ws_size, hipStream_t stream) {
    static int grid = 0;
    if (grid == 0) {
        if (n_in != 44 || out_size != TL * DM || ws_size < WS_END) { fprintf(stderr, "kernel_launch: unexpected problem (n_in %d, out %d, ws %zu < %zu)\n", n_in, out_size, ws_size, (size_t)WS_END); grid = -1; return; }
        int dev = 0, cus = 0, per_cu = 0;
        if (hipGetDevice(&dev) != hipSuccess || hipDeviceGetAttribute(&cus, hipDeviceAttributeMultiprocessorCount, dev) != hipSuccess) { grid = -1; return; }
        if (hipFuncSetAttribute((const void*)fwd_kernel, hipFuncAttributeMaxDynamicSharedMemorySize, LDS_BYTES) != hipSuccess) { fprintf(stderr, "kernel_launch: hipFuncSetAttribute failed\n"); grid = -1; return; }
        if (hipOccupancyMaxActiveBlocksPerMultiprocessor(&per_cu, (const void*)fwd_kernel, NTHR, LDS_BYTES) != hipSuccess || per_cu < 1) { fprintf(stderr, "kernel_launch: occupancy query says %d\n", per_cu); }
        (void)hipGetLastError();
        grid = cus;
    }
    if (grid < 0) return;
    (void)hipMemsetAsync((char*)d_ws + O_CTL, 0, SZ_CTL, stream);
    Args a{};
    for (int i = 0; i < 44; ++i) a.in[i] = (const float*)d_in[i];
    a.out = (float*)d_out; a.ws = (unsigned char*)d_ws;
#if MK_PER_PHASE
    for (int p = 0; p < N_PHASES; ++p) { a.ph_lo = p; a.ph_hi = p + 1; hipLaunchKernelGGL(fwd_kernel, dim3(grid), dim3(NTHR), LDS_BYTES, stream, a); }
#else
    a.ph_lo = 0; a.ph_hi = N_PHASES; hipLaunchKernelGGL(fwd_kernel, dim3(grid), dim3(NTHR), LDS_BYTES, stream, a);
#endif
}
```

```cpp
#include <hip/hip_runtime.h>
#include <cstdio>
#include <cstdint>

#define LAS __attribute__((address_space(3)))
#define GAS __attribute__((address_space(1)))
typedef unsigned short bf16;
typedef float f32x4 __attribute__((ext_vector_type(4)));
typedef float f32x16 __attribute__((ext_vector_type(16)));
typedef float f32x2 __attribute__((ext_vector_type(2)));
typedef unsigned u32x4 __attribute__((ext_vector_type(4)));
typedef unsigned u32x2 __attribute__((ext_vector_type(2)));
typedef short bf16x8 __attribute__((ext_vector_type(8)));

__device__ __forceinline__ unsigned f2bf(float f) { unsigned u = __float_as_uint(f); return (u + 0x7fffu + ((u >> 16) & 1u)) >> 16; }
__device__ __forceinline__ float bf2f(unsigned b) { return __uint_as_float(b << 16); }
__device__ __forceinline__ float bflo(unsigned w) { return __uint_as_float(w << 16); }
__device__ __forceinline__ float bfhi(unsigned w) { return __uint_as_float(w & 0xffff0000u); }
__device__ __forceinline__ unsigned pk2(float lo, float hi) { return f2bf(lo) | (f2bf(hi) << 16); }
__device__ __forceinline__ unsigned pack4_fp8(float a, float b, float c, float d) {
    a = fminf(fmaxf(a, -448.f), 448.f); b = fminf(fmaxf(b, -448.f), 448.f); c = fminf(fmaxf(c, -448.f), 448.f); d = fminf(fmaxf(d, -448.f), 448.f);
    int w = 0; w = __builtin_amdgcn_cvt_pk_fp8_f32(a, b, w, false); w = __builtin_amdgcn_cvt_pk_fp8_f32(c, d, w, true); return (unsigned)w; }
__device__ __forceinline__ float sigmoid_fast(float x) { return __builtin_amdgcn_rcpf(1.0f + __expf(-x)); }
__device__ __forceinline__ float sigmoid_acc(float x) { return 1.0f / (1.0f + expf(-x)); }
__device__ __forceinline__ float silu_acc(float x) { return x / (1.0f + expf(-x)); }
__device__ __forceinline__ float gelu_tanh(float x) { const float u = 0.7978845608028654f * (x + 0.044715f * x * x * x); const float t = 1.0f - 2.0f / (expf(2.0f * u) + 1.0f); return 0.5f * x * (1.0f + t); }
__device__ __forceinline__ float gelu_tanh_fast(float x) { const float u = 0.7978845608028654f * (x + 0.044715f * x * x * x); const float t = 1.0f - 2.0f * __builtin_amdgcn_rcpf(__expf(2.0f * u) + 1.0f); return 0.5f * x * (1.0f + t); }
__device__ __forceinline__ int tidx() { int t = threadIdx.x; asm volatile("" : "+v"(t)); return t; }
__device__ __forceinline__ int bidx() { int t = blockIdx.x; asm volatile("" : "+s"(t)); return t; }
__device__ __forceinline__ int gdim() { int t = gridDim.x; asm volatile("" : "+s"(t)); return t; }
__device__ __forceinline__ float wave_sum(float v) {
#pragma unroll
    for (int o = 1; o < 64; o <<= 1) v += __shfl_xor(v, o);
    return v;
}

namespace pg8 {
constexpr int BM = 256, BK = 64, HALF = 128, HTB = HALF * BK * 2, STAGE_BYTES = 8 * HTB, NXCD = 8, WGM = 8;
__host__ __device__ __forceinline__ int lds_byte(int r, int c) { const int st = (r >> 4) * 2 + (c >> 5), rr = r & 15, cc = c & 31, ob = rr * 64 + cc * 2; return st * 1024 + (ob ^ (((ob >> 9) & 1) << 5)); }
__host__ __device__ __forceinline__ void stage_rc(int b, int& R, int& C) { const int st = b / 1024, sb = b % 1024, swz = sb ^ (((sb >> 9) & 1) << 5); R = (st >> 1) * 16 + swz / 64; C = (st & 1) * 32 + (swz % 64) / 2; }
__host__ __device__ __forceinline__ int perm32(int rho) { const int n = rho >> 4, i = rho & 15; return 8 * (i >> 2) + 4 * n + (i & 3); }

struct Unit { int pa, pb, pm, pn, aux, k0, nkt, split; };
struct Gemm { const bf16* A; const bf16* Bt; int lda, ldb, K; };

struct StaticOrder {
    int nM, nN, nwg, G, c;
    __device__ void init(int nM_, int nN_, int G_, int c_) { nM = nM_; nN = nN_; nwg = nM * nN; G = G_; c = c_; }
    __device__ bool next(int i, Unit& u) const {
        const long L = (long)i * G + c; if (L >= nwg) return false;
        int wgid = (int)L; { const int q = nwg / NXCD, r = nwg % NXCD, xcd = wgid % NXCD, off = wgid / NXCD; wgid = (xcd < r ? xcd * (q + 1) : r * (q + 1) + (xcd - r) * q) + off; }
        const int nig = WGM * nN, gid = wgid / nig, fm = gid * WGM, gsz = (nM - fm) < WGM ? (nM - fm) : WGM;
        u.pm = fm + ((wgid % nig) % gsz); u.pn = (wgid % nig) / gsz; u.pa = u.pm; u.pb = u.pn; u.aux = 0; u.k0 = 0; u.nkt = 0; u.split = 0; return true;
    }
};
__device__ __forceinline__ unsigned cvt_pk_bf16(float lo, float hi) { unsigned r; asm volatile("v_cvt_pk_bf16_f32 %0, %1, %2" : "=v"(r) : "v"(lo), "v"(hi)); return r; }

#ifndef GEMM_SP2
#define GEMM_SP2 true
#endif
typedef int i32x8 __attribute__((ext_vector_type(8)));
typedef short s16x16 __attribute__((ext_vector_type(16)));
typedef int i32x4 __attribute__((ext_vector_type(4)));
template <bool F8> struct Frag;
template <> struct Frag<false> { bf16x8 p0, p1; };
template <> struct Frag<true> { i32x8 v; };
template <bool F8> __device__ __forceinline__ void frag_load(Frag<F8>& f, const LAS unsigned char* p) {
    if constexpr (F8) { f.v.lo = *(const LAS i32x4*)p; f.v.hi = *(const LAS i32x4*)(p + 1024); }
    else { f.p0 = *(const LAS bf16x8*)p; f.p1 = *(const LAS bf16x8*)(p + 1024); }
}
template <bool F8> __device__ __forceinline__ f32x4 mma_pair(const Frag<F8>& b, const Frag<F8>& a, f32x4 c) {
    if constexpr (F8) {
#if defined(__HIP_DEVICE_COMPILE__)
        asm volatile("v_mfma_f32_16x16x128_f8f6f4 %0, %1, %2, %0" : "+v"(c) : "v"(b.v), "v"(a.v));
#endif
        return c; }
    else { c = __builtin_amdgcn_mfma_f32_16x16x32_bf16(b.p0, a.p0, c, 0, 0, 0); return __builtin_amdgcn_mfma_f32_16x16x32_bf16(b.p1, a.p1, c, 0, 0, 0); }
}
template <class Epi, class Sched, bool F8 = false, bool ALIGN_EPI = true, bool SP2 = GEMM_SP2>
__device__ __forceinline__ void gemm_phase(LAS unsigned char* lds, const Gemm g, const Sched& S, const Epi& E) {
    const int tid = tidx(), wid = __builtin_amdgcn_readfirstlane(tid >> 6), lane = tid & 63, wr = wid >> 2, wc = wid & 3, fr = lane & 15, fq = lane >> 4;
    const int K = g.K, ntall = K / BK;
    unsigned voffA[2], voffB[2];
#pragma unroll
    for (int i = 0; i < 2; ++i) { int R, C; stage_rc(tid * 16 + i * 8192, R, C); const int Rb = Epi::PERM ? ((R & ~31) + perm32(R & 31)) : R;
        voffA[i] = (unsigned)(R * g.lda + C) * 2u; voffB[i] = (unsigned)(Rb * g.ldb + C) * 2u; }
    const size_t kstep = (size_t)(BK * 2);
    const size_t hstepA = (size_t)HALF * g.lda * 2, hstepB = (size_t)HALF * g.ldb * 2;
    const size_t tstepA = 2 * hstepA, tstepB = 2 * hstepB;
    const unsigned ldsw = (unsigned)wid * 1024u;
    const int aoff = lds_byte(wr * 64 + fr, fq * 8), boff = lds_byte(wc * 32 + fr, fq * 8);
#define PG8_SA(b, h) (((b) * 2 + (h)) * HTB)
#define PG8_SB(b, h) ((4 + (b) * 2 + (h)) * HTB)
#define PG8_STAGE(bufoff, gbase, voff) do { _Pragma("unroll") for (int _i = 0; _i < 2; ++_i) \
        __builtin_amdgcn_global_load_lds((const unsigned*)((const char*)(gbase) + (voff)[_i]), (LAS unsigned*)(lds + (bufoff) + ldsw + _i * 8192), 16, 0, 0); } while (0)
#define PG8_LDA(dst, b, h) do { _Pragma("unroll") for (int m = 0; m < 4; ++m) frag_load<F8>(dst[m], lds + PG8_SA(b, h) + aoff + m * 2048); } while (0)
#define PG8_LDB(dst, b, h) do { _Pragma("unroll") for (int n = 0; n < 2; ++n) frag_load<F8>(dst[n], lds + PG8_SB(b, h) + boff + n * 2048); } while (0)
#define PG8_MMA(ai, bj, At, Bt) do { __builtin_amdgcn_s_setprio(1); _Pragma("unroll") for (int m = 0; m < 4; ++m) _Pragma("unroll") for (int n = 0; n < 2; ++n) \
        acc[ai][bj][m][n] = mma_pair<F8>(Bt[n], At[m], acc[ai][bj][m][n]); __builtin_amdgcn_s_setprio(0); } while (0)
#define PG8_WAIT_V(n) asm volatile("s_waitcnt vmcnt(" #n ")" ::: "memory")
#define PG8_WAIT_L(n) asm volatile("s_waitcnt lgkmcnt(" #n ")" ::: "memory")
#define PG8_BAR __builtin_amdgcn_s_barrier()
#define PG8_SCHED __builtin_amdgcn_sched_barrier(0)
    Unit cur, nxt; int ui = 0;
    if (!S.next(0, cur)) return;
    f32x4 acc[2][2][4][2];
#pragma unroll
    for (int a = 0; a < 2; ++a)
#pragma unroll
        for (int b = 0; b < 2; ++b)
#pragma unroll
            for (int m = 0; m < 4; ++m)
#pragma unroll
                for (int n = 0; n < 2; ++n) acc[a][b][m][n] = (f32x4){0.f, 0.f, 0.f, 0.f};
    Frag<F8> At[4], B0[2], B1[2];
    const char* cA = (const char*)g.A + (size_t)cur.pa * tstepA + (size_t)cur.k0 * kstep; const char* cB = (const char*)g.Bt + (size_t)cur.pb * tstepB + (size_t)cur.k0 * kstep;
    if constexpr (SP2) {
        PG8_STAGE(PG8_SB(0, 0), cB, voffB); PG8_STAGE(PG8_SB(0, 1), cB + hstepB, voffB); PG8_STAGE(PG8_SA(0, 0), cA, voffA); PG8_STAGE(PG8_SA(0, 1), cA + hstepA, voffA);
        if (wr == 1) PG8_BAR;
        PG8_WAIT_V(2); PG8_BAR;
        PG8_STAGE(PG8_SB(1, 0), cB + kstep, voffB); PG8_STAGE(PG8_SA(1, 0), cA + kstep, voffA); PG8_STAGE(PG8_SB(1, 1), cB + hstepB + kstep, voffB);
        PG8_WAIT_V(6); PG8_BAR;
    } else {
        PG8_STAGE(PG8_SB(0, 0), cB, voffB); PG8_STAGE(PG8_SA(0, 0), cA, voffA); PG8_STAGE(PG8_SB(0, 1), cB + hstepB, voffB); PG8_STAGE(PG8_SA(0, 1), cA + hstepA, voffA);
        if (wr == 1) PG8_BAR;
        PG8_WAIT_V(4); PG8_BAR;
        PG8_STAGE(PG8_SB(1, 0), cB + kstep, voffB); PG8_STAGE(PG8_SA(1, 0), cA + kstep, voffA); PG8_STAGE(PG8_SB(1, 1), cB + hstepB + kstep, voffB);
        PG8_WAIT_V(6); PG8_BAR;
    }
    for (;;) {
        const bool has_next = S.next(ui + 1, nxt);
        const char* nA = has_next ? (const char*)g.A + (size_t)nxt.pa * tstepA + (size_t)nxt.k0 * kstep : cA; const char* nB = has_next ? (const char*)g.Bt + (size_t)nxt.pb * tstepB + (size_t)nxt.k0 * kstep : cB;
        const int nt = cur.nkt ? cur.nkt : ntall;
        for (int t = 0; t < nt; t += 2) {
            const bool last = (t == nt - 2);
            const char* a1 = cA + (size_t)(t + 1) * kstep;
            const char* a2 = last ? nA : cA + (size_t)(t + 2) * kstep; const char* b2 = last ? nB : cB + (size_t)(t + 2) * kstep;
            const char* a3 = a2 + kstep; const char* b3 = b2 + kstep;
            if constexpr (SP2) {
            PG8_LDB(B0, 0, 0); PG8_LDB(B1, 0, 1); PG8_SCHED; PG8_LDA(At, 0, 0); PG8_STAGE(PG8_SA(1, 1), a1 + hstepA, voffA);
            PG8_WAIT_V(8); PG8_WAIT_L(0); PG8_BAR; PG8_MMA(0, 0, At, B0); PG8_MMA(0, 1, At, B1); PG8_BAR; PG8_SCHED;
            PG8_LDA(At, 0, 1); PG8_STAGE(PG8_SB(0, 0), b2, voffB); PG8_STAGE(PG8_SB(0, 1), b2 + hstepB, voffB); PG8_STAGE(PG8_SA(0, 0), a2, voffA);
            PG8_WAIT_V(8); PG8_WAIT_L(0); PG8_BAR; PG8_MMA(1, 0, At, B0); PG8_MMA(1, 1, At, B1); PG8_BAR; PG8_SCHED;
            PG8_LDB(B0, 1, 0); PG8_LDB(B1, 1, 1); PG8_SCHED; PG8_LDA(At, 1, 0); PG8_STAGE(PG8_SA(0, 1), a2 + hstepA, voffA);
            PG8_WAIT_V(8); PG8_WAIT_L(0); PG8_BAR; PG8_MMA(0, 0, At, B0); PG8_MMA(0, 1, At, B1); PG8_BAR; PG8_SCHED;
            PG8_LDA(At, 1, 1); PG8_STAGE(PG8_SB(1, 0), b3, voffB); PG8_STAGE(PG8_SB(1, 1), b3 + hstepB, voffB); PG8_STAGE(PG8_SA(1, 0), a3, voffA);
            PG8_WAIT_V(8); PG8_WAIT_L(0); PG8_BAR; PG8_MMA(1, 0, At, B0); PG8_MMA(1, 1, At, B1); PG8_BAR; PG8_SCHED;
            } else {
            PG8_LDB(B0, 0, 0); PG8_SCHED; PG8_LDA(At, 0, 0); PG8_STAGE(PG8_SA(1, 1), a1 + hstepA, voffA);
            PG8_WAIT_L(8); PG8_BAR; PG8_WAIT_L(0); PG8_MMA(0, 0, At, B0); PG8_BAR; PG8_SCHED;
            PG8_LDB(B1, 0, 1); PG8_STAGE(PG8_SB(0, 0), b2, voffB);
            PG8_BAR; PG8_WAIT_L(0); PG8_MMA(0, 1, At, B1); PG8_BAR;
            PG8_LDA(At, 0, 1); PG8_STAGE(PG8_SA(0, 0), a2, voffA);
            PG8_BAR; PG8_WAIT_L(0); PG8_MMA(1, 0, At, B0); PG8_BAR; PG8_SCHED;
            PG8_STAGE(PG8_SB(0, 1), b2 + hstepB, voffB);
            PG8_WAIT_V(6); PG8_BAR; PG8_MMA(1, 1, At, B1); PG8_BAR;
            PG8_LDB(B0, 1, 0); PG8_SCHED; PG8_LDA(At, 1, 0); PG8_STAGE(PG8_SA(0, 1), a2 + hstepA, voffA);
            PG8_WAIT_L(8); PG8_BAR; PG8_WAIT_L(0); PG8_MMA(0, 0, At, B0); PG8_BAR; PG8_SCHED;
            PG8_LDB(B1, 1, 1); PG8_STAGE(PG8_SB(1, 0), b3, voffB);
            PG8_BAR; PG8_WAIT_L(0); PG8_MMA(0, 1, At, B1); PG8_BAR;
            PG8_LDA(At, 1, 1); PG8_STAGE(PG8_SA(1, 0), a3, voffA);
            PG8_BAR; PG8_WAIT_L(0); PG8_MMA(1, 0, At, B0); PG8_BAR; PG8_SCHED;
            PG8_STAGE(PG8_SB(1, 1), b3 + hstepB, voffB);
            PG8_WAIT_V(6); PG8_BAR; PG8_MMA(1, 1, At, B1); PG8_BAR;
            }
        }
        if constexpr (ALIGN_EPI) { if (wr == 0) PG8_BAR; }
        { int fr2 = fr, fq2 = fq; asm volatile("" : "+v"(fr2), "+v"(fq2)); E(acc, cur, wr, wc, fr2, fq2); }
        if (!has_next) break;
#pragma unroll
        for (int a = 0; a < 2; ++a)
#pragma unroll
            for (int b = 0; b < 2; ++b)
#pragma unroll
                for (int m = 0; m < 4; ++m)
#pragma unroll
                    for (int n = 0; n < 2; ++n) acc[a][b][m][n] = (f32x4){0.f, 0.f, 0.f, 0.f};
        cur = nxt; cA = nA; cB = nB; ++ui;
        if constexpr (ALIGN_EPI) { if (wr == 1) PG8_BAR; }
    }
    PG8_WAIT_V(0);
    if constexpr (!ALIGN_EPI) { if (wr == 0) PG8_BAR; }
    PG8_BAR;
#undef PG8_SA
#undef PG8_SB
#undef PG8_STAGE
#undef PG8_LDA
#undef PG8_LDB
#undef PG8_MMA
#undef PG8_WAIT_V
#undef PG8_WAIT_L
#undef PG8_BAR
#undef PG8_SCHED
}
}

#define XB_TMO      128
#define XB_XCNT(j)  (256  + 64 * (j))
#define XB_XSUB(j)  (1280 + 64 * (j))
#define XB_XGEN(j)  (2304 + 64 * (j))
#define XB_TOP      3328
#define XB_TOPGEN   3392
#define XCD_BAR_WORDS 3456
#define XB_SPIN_CAP (1u << 20)
__device__ __forceinline__ unsigned xb_ld(unsigned* p)              { return __hip_atomic_load(p, __ATOMIC_RELAXED, __HIP_MEMORY_SCOPE_AGENT); }
__device__ __forceinline__ unsigned xb_add(unsigned* p, unsigned v) { return __hip_atomic_fetch_add(p, v, __ATOMIC_RELAXED, __HIP_MEMORY_SCOPE_AGENT); }
__device__ __forceinline__ unsigned xb_xcc_id() { return (unsigned)__builtin_amdgcn_s_getreg((3 << 11) | 20) & 0xFu; }
#define XB_SPIN(cond, bar) do { unsigned _sp = 0; while (cond) { __builtin_amdgcn_s_sleep(1); \
    if ((++_sp & 255u) == 0u) { if (xb_ld(&(bar)[XB_TMO])) break; if (_sp > XB_SPIN_CAP) { atomicAdd(&(bar)[XB_TMO], 1u); break; } } } } while (0)
struct XcdBarrier { unsigned* bar; unsigned x; volatile LAS unsigned* st; };
__device__ __forceinline__ XcdBarrier xcd_barrier_post(unsigned* bar, volatile LAS unsigned* st) {
    XcdBarrier b; b.bar = bar; b.x = xb_xcc_id(); b.st = st;
    if (threadIdx.x == 0) (void)xb_add(&bar[XB_XCNT(b.x)], 1u);
    return b;
}
__device__ __forceinline__ void xcd_barrier_complete(unsigned* bar, unsigned x, unsigned& nloc, unsigned& nx) {
    const unsigned G = gridDim.x * gridDim.y * gridDim.z;
    unsigned sum, cnt, mine, sp = 0u;
    for (;;) {
        sum = 0u; cnt = 0u; mine = 0u;
#pragma unroll
        for (unsigned j = 0; j < 16; ++j) { const unsigned c = xb_ld(&bar[XB_XCNT(j)]); sum += c; cnt += (c > 0u) ? 1u : 0u; mine = (j == x) ? c : mine; }
        if (sum == G) break;
        __builtin_amdgcn_s_sleep(1);
        if ((++sp & 255u) == 0u) { if (xb_ld(&bar[XB_TMO])) break; if (sp > XB_SPIN_CAP) { atomicAdd(&bar[XB_TMO], 1u); break; } }
    }
    nloc = mine > 0u ? mine : 1u; nx = cnt > 0u ? cnt : 1u;
}
__device__ __forceinline__ void xcd_barrier(const XcdBarrier& b) {
    asm volatile("s_waitcnt vmcnt(0)" ::: "memory");
    __syncthreads();
    if (threadIdx.x == 0) {
        unsigned* bar = b.bar;
        __builtin_amdgcn_s_waitcnt(0);
        unsigned nloc = b.st[0], nx = b.st[1];
        if (nloc == 0u) { xcd_barrier_complete(bar, b.x, nloc, nx); b.st[0] = nloc; b.st[1] = nx; }
        const unsigned old = xb_add(&bar[XB_XSUB(b.x)], 1u);
        const unsigned gen = old / nloc;
        if (old + 1u == (gen + 1u) * nloc) {
            __builtin_amdgcn_fence(__ATOMIC_RELEASE, "agent");
            asm volatile("s_waitcnt vmcnt(0)" ::: "memory");
            const unsigned og = xb_add(&bar[XB_TOP], 1u);
            const unsigned tg = og / nx;
            if (og + 1u == (tg + 1u) * nx) xb_add(&bar[XB_TOPGEN], 1u);
            else XB_SPIN(xb_ld(&bar[XB_TOPGEN]) == tg, bar);
            __builtin_amdgcn_fence(__ATOMIC_ACQUIRE, "agent");
            xb_add(&bar[XB_XGEN(b.x)], 1u);
            asm volatile("s_waitcnt vmcnt(0)" ::: "memory");
        } else {
            XB_SPIN(xb_ld(&bar[XB_XGEN(b.x)]) == gen, bar);
            __builtin_amdgcn_fence(__ATOMIC_ACQUIRE, "agent");
            asm volatile("s_waitcnt vmcnt(0)" ::: "memory");
        }
    }
    __syncthreads();
}

constexpr int DM = 1024, NBATCH = 4, SEQL = 8192, CTXL = 256;
constexpr int TL = NBATCH * SEQL, TCX = NBATCH * CTXL, TT = TL + TCX;
constexpr int NCHK = TT / 64;
constexpr int NRT = TT / 256;
constexpr int INC = 6688, NINP = 6912, PMC = 2560, SGC = 4096;
constexpr int DFF = 2816, DEX = 3584, NEX = 8;
constexpr int MOE_ROWS = 34816;
constexpr float EPS = 1e-6f;
constexpr int NTHR = 512, NWAVE = 8;
constexpr int LDS_BYTES = 147456;
constexpr int LDS_MISC = 144384;

constexpr size_t al4k(size_t x) { return (x + 4095) & ~(size_t)4095; }
constexpr size_t O_CTL = 0,                          SZ_CTL = 1u << 20;
constexpr size_t O_MODS = O_CTL + SZ_CTL,            SZ_MODS = al4k((size_t)2 * 5 * 6144 * 4);
constexpr size_t O_TW = O_MODS + SZ_MODS,            SZ_TW = 8192 * 8 + (size_t)192 * 512 * 4;
constexpr size_t O_PE = O_TW + 8192 * 8;
constexpr size_t O_HFIL = O_TW + SZ_TW,              SZ_HFIL = (size_t)2 * 512 * 8192 * 4;
constexpr size_t O_HPS = O_HFIL + SZ_HFIL,           SZ_HPS = (size_t)2 * 512 * 128 * 4;
constexpr size_t O_HFILC = O_HPS + SZ_HPS,           SZ_HFILC = (size_t)512 * 256 * 4;
constexpr size_t O_HPSC = O_HFILC + SZ_HFILC,        SZ_HPSC = al4k(512 * 4 * 4);
constexpr size_t O_XCTX = O_HPSC + SZ_HPSC,          SZ_XCTX = (size_t)TCX * DM * 4;
constexpr size_t O_TOKI = O_XCTX + SZ_XCTX,          SZ_TOKI = (size_t)TL * 16 + (size_t)TL * 8;
constexpr size_t O_TPOS = O_TOKI + (size_t)TL * 16;
constexpr size_t O_RTOK = O_TOKI + SZ_TOKI,          SZ_RTOK = al4k((size_t)2 * MOE_ROWS * 4);
constexpr size_t O_RW = O_RTOK + SZ_RTOK,            SZ_RW = al4k((size_t)2 * MOE_ROWS * 4);
constexpr size_t O_GDEC = O_RW + SZ_RW,              SZ_GDEC = al4k((size_t)8 * NCHK * 64 * 4);
constexpr size_t O_RGP = O_GDEC + SZ_GDEC,           SZ_RGP = al4k((size_t)2 * NCHK * 256 * 4);
constexpr size_t O_RGH = O_RGP + SZ_RGP,             SZ_RGH = SZ_RGP;
constexpr size_t O_S5PW = O_RGH + SZ_RGH,           SZ_S5PW = al4k((size_t)2 * 16 * 2 * 65 * 64 * 8);
constexpr size_t O_S5Q = O_S5PW + SZ_S5PW,           SZ_S5Q = al4k((size_t)2 * 16 * 2 * 64 * 8);
constexpr size_t O_S5K = O_S5Q + SZ_S5Q,             SZ_S5K = (size_t)2 * 16 * 2 * 64 * 256 * 4;
constexpr size_t O_WRG = O_S5K + SZ_S5K,             SZ_WRG = (size_t)2 * 1024 * 256 * 2;
constexpr size_t O_RGSP = O_WRG + SZ_WRG,            SZ_RGSP = al4k(2 * 2 * 256 * 4);
constexpr size_t O_WIN = O_RGSP + SZ_RGSP,             SZ_WIN = (size_t)2 * NINP * DM * 2;
constexpr size_t O_WBR = O_WIN + SZ_WIN,             SZ_WBR = (size_t)2 * 4 * 1024 * 256 * 2;
constexpr size_t O_WOUT = O_WBR + SZ_WBR,            SZ_WOUT = (size_t)2 * 1024 * 1024 * 2;
constexpr size_t O_WGU = O_WOUT + SZ_WOUT,           SZ_WGU = (size_t)2 * DFF * DM * 2;
constexpr size_t O_WDN = O_WGU + SZ_WGU,             SZ_WDN = (size_t)DM * DFF * 2;
constexpr size_t O_WGLU = O_WDN + SZ_WDN,            SZ_WGLU = (size_t)2 * 256 * 256 * 2;
constexpr size_t O_H = O_WGLU + SZ_WGLU,             SZ_H = (size_t)TT * DM * 2;
constexpr size_t O_PM = O_H + SZ_H,                  SZ_PM = (size_t)TT * PMC * 2;
constexpr size_t O_SG = O_PM + SZ_PM,                SZ_SG = (size_t)TT * SGC * 2;
constexpr size_t O_GDN = O_SG + SZ_SG,               SZ_GDN = al4k((size_t)TT * 32 * 2);
constexpr size_t O_BR = O_GDN + SZ_GDN,              SZ_BR = (size_t)4 * TT * 256 * 2;
constexpr size_t O_UH = O_BR + SZ_BR,                SZ_UH = (size_t)16 * 768 * 1280 * 2;
constexpr size_t O_TCM = O_UH + SZ_UH,               SZ_TCM = (size_t)16 * 1024 * 1280 * 2;
constexpr size_t O_BPOW = O_TCM + SZ_TCM,            SZ_BPOW = (size_t)16 * 256 * 1024 * 2;
constexpr size_t O_HC = O_BPOW + SZ_BPOW,            SZ_HC = (size_t)16 * 768 * 256 * 4;
constexpr size_t O_GBUF = O_HC + SZ_HC,              SZ_GBUF = (size_t)TT * 256 * 2;
constexpr size_t O_ZT = O_GBUF + SZ_GBUF,            SZ_ZT = (size_t)4 * 256 * 8192 * 4;
constexpr size_t O_ZC = O_ZT + SZ_ZT,                SZ_ZC = (size_t)4 * 256 * 256 * 4;
constexpr size_t O_CZC = O_ZC + SZ_ZC,               SZ_CZC = SZ_ZC;
constexpr size_t O_GS = O_BR,                        SZ_GS = 0;
constexpr size_t O_GS16 = O_SG + (size_t)TT * SGC;
constexpr size_t O_XC = O_BR + (size_t)3 * TT * 256 * 2;
constexpr size_t O_ENDZ = O_CZC + SZ_CZC;
constexpr size_t O_RLA = O_ENDZ,                      SZ_RLA = (size_t)2 * TT * 256 * 2;
constexpr size_t O_RBT = O_RLA + SZ_RLA,             SZ_RBT = SZ_RLA;
constexpr size_t WS_END = O_RBT + SZ_RBT;
constexpr size_t O_CZT = O_ZT;
constexpr size_t O_YMF = O_PM;
constexpr size_t O_FMID = O_PM;
constexpr size_t O_XB = O_SG + (size_t)TT * SGC + (size_t)8 * NCHK * 4096 * 2, SZ_XB = (size_t)TT * DM * 2;
constexpr size_t O_MWGU = O_PM,                      SZ_MWGU = (size_t)NEX * 2 * DEX * DM;
constexpr size_t O_MWDN = O_MWGU + SZ_MWGU,          SZ_MWDN = (size_t)NEX * DM * DEX;
constexpr size_t O_H2S = O_MWDN + SZ_MWDN,           SZ_H2S = (size_t)2 * MOE_ROWS * DM * 2;
constexpr size_t O_MMID = O_XB + SZ_XB,              SZ_MMID = (size_t)MOE_ROWS * DEX * 2;
static_assert((size_t)TT * DFF <= O_XB - O_PM && O_H2S + SZ_H2S <= O_XB && O_XB + SZ_XB <= O_SG + SZ_SG && O_MMID + SZ_MMID <= WS_END, "overlays");
static_assert((size_t)8 * NCHK * 4096 * 4 <= SZ_H && (size_t)TT * SGC + (size_t)8 * NCHK * 4096 * 2 <= SZ_SG, "GLA states fit the h buffer / the spare half of the gate buffer");
constexpr int CW_BAR = 4096, CW_CNT = 8192, CW_BLK = 16384;

struct Args { const float* in[44]; float* out; unsigned char* ws; int ph_lo, ph_hi; };
typedef const __attribute__((address_space(4))) Args CArgs;
__device__ __forceinline__ CArgs* kargs() { CArgs* p = (CArgs*)__builtin_amdgcn_kernarg_segment_ptr(); asm volatile("" : "+s"(p)); return p; }
#define KA (*kargs())
enum { I_X = 0, I_C, I_CTX, I_CCTX, I_MODW, I_MODB, I_N1G, I_N2G, I_WIN, I_GWUP, I_GBUP, I_LRE, I_LIM, I_LDT, I_BRE, I_BIM, I_CRE, I_CIM, I_S5D, I_WGLU, I_BGLU,
       I_HWS, I_HW1, I_HB1, I_HW2, I_HB2, I_HW3, I_HFR, I_HBIAS, I_RWC, I_RWA, I_RBA, I_RWX, I_RBX, I_RLAM, I_WBR, I_WOUT, I_FGU, I_FDN, I_MRT, I_MRB, I_MGU, I_MDN, I_FING };

#define WSP(T, off) ((T*)(A.ws + (off)))

__device__ __forceinline__ int seq_chunk(int b, int d, int step) {
    if (step < 4) return 512 + 4 * b + (d ? 3 - step : step);
    const int c = step - 4; return 128 * b + (d ? 127 - c : c);
}
__device__ __forceinline__ void seq_bounds(int n, int& s0, int& s1) {
    if (n < 512) { s0 = (n >> 7) * SEQL; s1 = s0 + SEQL; } else { s0 = TL + ((n - 512) >> 2) * CTXL; s1 = s0 + CTXL; }
}

__device__ __forceinline__ void transpose_item(const float* W, int N, int k0, int n0, bf16* WT, int drow0, int ldk, LAS float* scr, int lane) {
    const float* src = W + (size_t)(k0 + (lane >> 3)) * N + n0 + 4 * (lane & 7);
    f32x4 v[16];
#pragma unroll
    for (int i = 0; i < 16; ++i) v[i] = __builtin_nontemporal_load((const f32x4*)(src + (size_t)(8 * i) * N));
#pragma unroll
    for (int i = 0; i < 16; ++i) { LAS float* d = scr + (8 * i + (lane >> 3)) * 33 + 4 * (lane & 7); d[0] = v[i][0]; d[1] = v[i][1]; d[2] = v[i][2]; d[3] = v[i][3]; }
    asm volatile("s_waitcnt lgkmcnt(0)" ::: "memory");
    const int kg = lane & 15;
#pragma unroll
    for (int q = 0; q < 8; ++q) { const int n = (lane >> 4) + 4 * q; const LAS float* s = scr + (8 * kg) * 33 + n;
        u32x4 o; o.x = pk2(s[0], s[33]); o.y = pk2(s[66], s[99]); o.z = pk2(s[132], s[165]); o.w = pk2(s[198], s[231]);
        *(u32x4*)(WT + (size_t)(drow0 + n) * ldk + k0 + 8 * kg) = o; }
    asm volatile("s_waitcnt lgkmcnt(0)" ::: "memory");
}
__device__ __forceinline__ void transpose_item8(const float* W, int N, int k0, int n0, unsigned char* WT, int drow0, int ldk, LAS float* scr, int lane) {
    const float* src = W + (size_t)(k0 + (lane >> 3)) * N + n0 + 4 * (lane & 7);
    f32x4 v[16];
#pragma unroll
    for (int i = 0; i < 16; ++i) v[i] = __builtin_nontemporal_load((const f32x4*)(src + (size_t)(8 * i) * N));
#pragma unroll
    for (int i = 0; i < 16; ++i) { LAS float* d = scr + (8 * i + (lane >> 3)) * 33 + 4 * (lane & 7); d[0] = v[i][0]; d[1] = v[i][1]; d[2] = v[i][2]; d[3] = v[i][3]; }
    asm volatile("s_waitcnt lgkmcnt(0)" ::: "memory");
    const int kg = lane & 7;
#pragma unroll
    for (int q = 0; q < 4; ++q) { const int n = (lane >> 3) + 8 * q; const LAS float* s = scr + (16 * kg) * 33 + n;
        u32x4 o; o.x = pack4_fp8(32.f * s[0], 32.f * s[33], 32.f * s[66], 32.f * s[99]); o.y = pack4_fp8(32.f * s[132], 32.f * s[165], 32.f * s[198], 32.f * s[231]);
        o.z = pack4_fp8(32.f * s[264], 32.f * s[297], 32.f * s[330], 32.f * s[363]); o.w = pack4_fp8(32.f * s[396], 32.f * s[429], 32.f * s[462], 32.f * s[495]);
        *(u32x4*)(WT + (size_t)(drow0 + n) * ldk + k0 + 16 * kg) = o; }
    asm volatile("s_waitcnt lgkmcnt(0)" ::: "memory");
}
__device__ __forceinline__ void transpose_item8_64(const float* W, int N, int k0, int n0, unsigned char* WT, int drow0, int ldk, LAS float* scr, int lane) {
    const float* src = W + (size_t)(k0 + (lane >> 4)) * N + n0 + 4 * (lane & 15);
    f32x4 v[16];
#pragma unroll
    for (int i = 0; i < 16; ++i) v[i] = __builtin_nontemporal_load((const f32x4*)(src + (size_t)(4 * i) * N));
#pragma unroll
    for (int i = 0; i < 16; ++i) { LAS float* d = scr + (4 * i + (lane >> 4)) * 65 + 4 * (lane & 15); d[0] = v[i][0]; d[1] = v[i][1]; d[2] = v[i][2]; d[3] = v[i][3]; }
    asm volatile("s_waitcnt lgkmcnt(0)" ::: "memory");
    const int kg = lane & 3;
#pragma unroll
    for (int q = 0; q < 4; ++q) { const int n = (lane >> 2) + 16 * q; const LAS float* s = scr + (16 * kg) * 65 + n;
        u32x4 o; o.x = pack4_fp8(32.f * s[0], 32.f * s[65], 32.f * s[130], 32.f * s[195]); o.y = pack4_fp8(32.f * s[260], 32.f * s[325], 32.f * s[390], 32.f * s[455]);
        o.z = pack4_fp8(32.f * s[520], 32.f * s[585], 32.f * s[650], 32.f * s[715]); o.w = pack4_fp8(32.f * s[780], 32.f * s[845], 32.f * s[910], 32.f * s[975]);
        *(u32x4*)(WT + (size_t)(drow0 + n) * ldk + k0 + 16 * kg) = o; }
    asm volatile("s_waitcnt lgkmcnt(0)" ::: "memory");
}
__device__ __forceinline__ int inproj_dest(int n0) {
    if (n0 < 1024) return n0;
    if (n0 < 1056) return 6656 + (n0 - 1024);
    if (n0 < 1312) return 1024 + (n0 - 1056);
    if (n0 < 2080) return 1280 + (n0 - 1312);
    if (n0 < 2592) return 2048 + (n0 - 2080);
    return 2560 + (n0 - 2592);
}
__device__ __forceinline__ int swiglu_dest(int n0, int dh) { return n0 < dh ? (n0 / 128) * 256 + (n0 % 128) : ((n0 - dh) / 128) * 256 + 128 + ((n0 - dh) % 128); }

#ifndef PRO_DUP
#define PRO_DUP 0
#endif
__device__ __forceinline__ void s5_tables(CArgs& A);
__device__ __forceinline__ void s5_ktable_unit(CArgs& A, LAS unsigned char* lds, int u);
__device__ __forceinline__ void ph_prologue(CArgs& A, LAS unsigned char* lds) {
    const int tid = tidx(), lane = tid & 63, wave = tid >> 6, G = gdim();
    const int gw = bidx() * NWAVE + wave, NGW = G * NWAVE;
    for (int rp = 0; rp < (PRO_DUP == 1 ? 2 : 1); ++rp) for (int u = bidx(); u < 256; u += G) s5_ktable_unit(A, lds, u);
    s5_tables(A);
    LAS float* scr = (LAS float*)(lds + wave * 17408);
    constexpr int I_IN = 2 * 8 * 209, I_BR = 8 * 64, I_OUT = 2 * 256, I_GU = 8 * 176, I_DN = 22 * 32, I_GL = 2 * 16;
    constexpr int NIT = I_IN + I_BR + I_OUT + I_GU + I_DN + I_GL;
    for (int rp = 0; rp < (PRO_DUP == 2 ? 2 : 1); ++rp) for (int it = gw; it < NIT; it += NGW) {
        int r = it;
        if (r < I_IN) { const int l = r / 1672, r2 = r % 1672, kb = r2 / 209, nb = r2 % 209;
            transpose_item(A.in[I_WIN] + (size_t)l * DM * INC, INC, kb * 128, nb * 32, WSP(bf16, O_WIN) + (size_t)l * NINP * DM, inproj_dest(nb * 32), DM, scr, lane); continue; } r -= I_IN;
        if (r < I_BR) { const int m = r / 64, r2 = r % 64, kb = r2 / 32, nb = r2 % 32;
            transpose_item(A.in[I_WBR] + (size_t)m * 256 * 1024, 1024, kb * 128, nb * 32, WSP(bf16, O_WBR) + (size_t)m * 1024 * 256, nb * 32, 256, scr, lane); continue; } r -= I_BR;
        if (r < I_OUT) { const int l = r / 256, r2 = r % 256, kb = r2 / 32, nb = r2 % 32;
            transpose_item(A.in[I_WOUT] + (size_t)l * 1024 * 1024, 1024, kb * 128, nb * 32, WSP(bf16, O_WOUT) + (size_t)l * 1024 * 1024, nb * 32, 1024, scr, lane); continue; } r -= I_OUT;
        if (r < I_GU) { const int kb = r / 176, nb = r % 176;
            transpose_item8(A.in[I_FGU], 2 * DFF, kb * 128, nb * 32, WSP(unsigned char, O_WGU), swiglu_dest(nb * 32, DFF), DM, scr, lane); continue; } r -= I_GU;
        if (r < I_DN) { const int kb = r / 32, nb = r % 32;
            transpose_item8(A.in[I_FDN], DM, kb * 128, nb * 32, WSP(unsigned char, O_WDN), nb * 32, DFF, scr, lane); continue; } r -= I_DN;
        { const int l = r / 16, r2 = r % 16, kb = r2 / 8, nb = r2 % 8;
            transpose_item(A.in[I_WGLU] + (size_t)l * 65536, 256, kb * 128, nb * 32, WSP(bf16, O_WGLU) + (size_t)l * 65536, nb * 32, 256, scr, lane); }
    }
    const int gt = bidx() * NTHR + tid, NT = G * NTHR;
    for (int i = gt; i < 2 * 224 * 128; i += NT) { const int l = i / (224 * 128), r2 = i % (224 * 128);
        *(u32x4*)(WSP(bf16, O_WIN) + ((size_t)l * NINP + INC) * DM + (size_t)r2 * 8) = (u32x4){0u, 0u, 0u, 0u}; }
    for (int i = gt; i < 8192; i += NT) { float s, c; sincospif(-(float)i * (1.0f / 8192.0f), &s, &c); WSP(f32x2, O_TW)[i] = (f32x2){c, s}; }
    for (int i = gt; i < 192 * 256; i += NT) { const int p = i >> 8, k = i & 255; const float om = expf(-(float)k * (9.210340371976184f / 256.0f)); const float a = (float)(p < 128 ? p : p - 128) * om; float sn, cs; sincosf(a, &sn, &cs);
        WSP(float, O_PE)[p * 512 + k] = sn; WSP(float, O_PE)[p * 512 + 256 + k] = cs; }
    for (int i = gt; i < 2 * 1024 * 256; i += NT) { const int l = i >> 18, row = (i >> 8) & 1023, k = i & 255, tile = row >> 8, d = tile >> 1, hf = tile & 1, which = (row >> 7) & 1, ch = hf * 128 + (row & 127), blk = ch >> 6;
        const float* w = A.in[which ? I_RWX : I_RWA]; const float v = ((k >> 6) == blk) ? w[((size_t)(((l * 2 + d) * 4 + blk) * 64 + (k & 63))) * 64 + (ch & 63)] : 0.f;
        WSP(bf16, O_WRG)[i] = (bf16)f2bf(v); }
    for (int i = gt; i < 2 * 2 * 256; i += NT) WSP(float, O_RGSP)[i] = log1pf(expf(-A.in[I_RLAM][i]));
    __syncthreads();
    {
        LAS float* sSilu = (LAS float*)lds; LAS float* sRed = (LAS float*)(lds + 20480);
        for (int rp = 0; rp < (PRO_DUP == 3 ? 2 : 1); ++rp) for (int u = (G == 256 ? bidx() - 64 : bidx()); u < 192; u += G) {
            if (u < 0) continue;
            const int l = u / 96, cb = u % 96;
            for (int i = tid; i < 5120; i += NTHR) { const int cnd = i >> 10, k = i & 1023; const float v = cnd < 4 ? A.in[I_C][cnd * 1024 + k] : A.in[I_CCTX][k]; sSilu[i] = silu_acc(v); }
            __syncthreads();
            float acc[5] = {0.f, 0.f, 0.f, 0.f, 0.f};
            const float* wp = A.in[I_MODW] + (size_t)l * DM * 6144 + cb * 64 + lane;
            for (int k0 = wave * 128; k0 < wave * 128 + 128; k0 += 32) { float wv[32];
#pragma unroll
                for (int q = 0; q < 32; ++q) wv[q] = wp[(size_t)(k0 + q) * 6144];
#pragma unroll
                for (int q = 0; q < 32; ++q)
#pragma unroll
                    for (int c = 0; c < 5; ++c) acc[c] += sSilu[c * 1024 + k0 + q] * wv[q]; }
#pragma unroll
            for (int c = 0; c < 5; ++c) sRed[(wave * 5 + c) * 64 + lane] = acc[c];
            __syncthreads();
            if (tid < 320) { const int c = tid >> 6, ln = tid & 63; float s = A.in[I_MODB][l * 6144 + cb * 64 + ln];
#pragma unroll
                for (int w = 0; w < 8; ++w) s += sRed[(w * 5 + c) * 64 + ln];
                WSP(float, O_MODS)[(l * 5 + c) * 6144 + cb * 64 + ln] = s; }
            __syncthreads();
        }
    }
    {
        LAS float* zf = (LAS float*)lds; LAS float* h1 = (LAS float*)(lds + 8448); LAS float* h2 = (LAS float*)(lds + 8448 + 16384);
        for (int rp = 0; rp < (PRO_DUP == 4 ? 2 : 1); ++rp) for (int u = bidx(); u < 260; u += G) {
            const int l = u < 256 ? u / 128 : 0, tb = u < 256 ? u % 128 : u - 256, ntok = u < 256 ? 8192 : 256, nps = u < 256 ? 128 : 4;
            float* outp = u < 256 ? WSP(float, O_HFIL) + (size_t)l * 512 * 8192 : WSP(float, O_HFILC);
            float* psp = u < 256 ? WSP(float, O_HPS) + (size_t)l * 512 * 128 : WSP(float, O_HPSC);
            const int t0 = tb * 64;
            for (int idx = tid; idx < 64 * 33; idx += NTHR) { const int pos = idx / 33, f = idx % 33; const double t = (double)(t0 + pos); float v;
                if (f == 0) v = (float)(t / ntok);
                else { const int kk = (f - 1) & 15; const double band = 1e-4 + kk * ((15.0 - 1e-4) / 15.0); const double angp = 2.0 * band * t / ntok; v = f <= 16 ? (float)cospi(angp) : (float)sinpi(angp); }
                zf[idx] = v; }
            __syncthreads();
            { const int j = tid & 63, pg = tid >> 6; const float fr = A.in[I_HFR][l * 64 + j], bb = A.in[I_HB1][l * 64 + j];
              float s[8];
#pragma unroll
              for (int i = 0; i < 8; ++i) s[i] = bb;
              float w1r[33];
#pragma unroll
              for (int f = 0; f < 33; ++f) w1r[f] = A.in[I_HW1][(l * 33 + f) * 64 + j];
#pragma unroll
              for (int f = 0; f < 33; ++f) {
#pragma unroll
                  for (int i = 0; i < 8; ++i) s[i] += zf[(pg * 8 + i) * 33 + f] * w1r[f]; }
#pragma unroll
              for (int i = 0; i < 8; ++i) h1[(pg * 8 + i) * 64 + j] = s[i];
#pragma unroll 1
              for (int i = 0; i < 8; ++i) { LAS float* hp_ = h1 + (pg * 8 + i) * 64 + j; *hp_ = sinf(fr * *hp_); } }
            __syncthreads();
            { const int j = tid & 63, pg = tid >> 6; const float fr = A.in[I_HFR][l * 64 + j], bb = A.in[I_HB2][l * 64 + j];
              float s[8];
#pragma unroll
              for (int i = 0; i < 8; ++i) s[i] = bb;
              float w2r[64];
#pragma unroll
              for (int f = 0; f < 64; ++f) w2r[f] = A.in[I_HW2][(l * 64 + f) * 64 + j];
#pragma unroll
              for (int f = 0; f < 64; ++f) {
#pragma unroll
                  for (int i = 0; i < 8; ++i) s[i] += h1[(pg * 8 + i) * 64 + f] * w2r[f]; }
#pragma unroll
              for (int i = 0; i < 8; ++i) h2[(pg * 8 + i) * 65 + j] = s[i];
#pragma unroll 1
              for (int i = 0; i < 8; ++i) { LAS float* hp_ = h2 + (pg * 8 + i) * 65 + j; *hp_ = sinf(fr * *hp_); } }
            __syncthreads();
            {
              const int lane = tid & 63, w = tid >> 6, l31 = lane & 31, kh = lane >> 5;
              const float dlo = -4.605170185988091f / 0.3f, dhi = -4.605170185988091f / 1.5f;
              const float inv = 1.0f / (float)(ntok - 1);
              const float* w3p = A.in[I_HW3] + (size_t)l * 64 * 512 + w * 64 + l31; float bw[2][32];
#pragma unroll
              for (int ks = 0; ks < 32; ++ks) { bw[0][ks] = w3p[(2 * ks + kh) * 512]; bw[1][ks] = w3p[(2 * ks + kh) * 512 + 32]; }
              f32x16 acc[2][2];
#pragma unroll
              for (int i = 0; i < 16; ++i) { acc[0][0][i] = 0.f; acc[0][1][i] = 0.f; acc[1][0][i] = 0.f; acc[1][1][i] = 0.f; }
#pragma unroll
              for (int ks = 0; ks < 32; ++ks) { const float a0 = h2[l31 * 65 + 2 * ks + kh], a1 = h2[(32 + l31) * 65 + 2 * ks + kh];
                  acc[0][0] = __builtin_amdgcn_mfma_f32_32x32x2f32(a0, bw[0][ks], acc[0][0], 0, 0, 0); acc[0][1] = __builtin_amdgcn_mfma_f32_32x32x2f32(a0, bw[1][ks], acc[0][1], 0, 0, 0);
                  acc[1][0] = __builtin_amdgcn_mfma_f32_32x32x2f32(a1, bw[0][ks], acc[1][0], 0, 0, 0); acc[1][1] = __builtin_amdgcn_mfma_f32_32x32x2f32(a1, bw[1][ks], acc[1][1], 0, 0, 0); }
#pragma unroll
              for (int ct = 0; ct < 2; ++ct) { const int c = w * 64 + ct * 32 + l31; const float delta = fabsf(dlo + (float)(c & 255) * ((dhi - dlo) / 255.0f)); float asum = 0.f;
#pragma unroll
                  for (int rt = 0; rt < 2; ++rt)
#pragma unroll
                      for (int i4 = 0; i4 < 4; ++i4) { const int pos = 32 * rt + 8 * i4 + 4 * kh; f32x4 o;
#pragma unroll
                          for (int e = 0; e < 4; ++e) { const float val = acc[rt][ct][4 * i4 + e] * expf(-((float)(t0 + pos + e) * inv) * delta); o[e] = val; asum += fabsf(val); }
                          *(f32x4*)(outp + (size_t)c * ntok + t0 + pos) = o; }
                  asum += __shfl_xor(asum, 32); if (kh == 0) psp[c * nps + tb] = asum; } }
            __syncthreads();
        }
    }
}

__device__ __forceinline__ void ph_norm(CArgs& A, LAS unsigned char* lds, int l, int which, bool first, bool router) {
    const int tid = tidx(), lane = tid & 63, wave = tid >> 6, G = gdim();
    const int gw = bidx() * NWAVE + wave, NGW = G * NWAVE;
    const int nrows = router ? TL : TT;
    LAS unsigned* sCnt = (LAS unsigned*)lds; const int tpb = TL / G;
    if (router) { if (tid < 16) sCnt[tid] = 0u; __syncthreads(); }
    const float* gp = A.in[which ? I_N2G : I_N1G] + l * DM;
    bf16* H = WSP(bf16, O_H);
    const float* xin = A.in[I_X]; const float* cin = A.in[I_CTX]; bf16* XB = WSP(bf16, O_XB);
#define NORM_SRC(r) ((r) < TL ? xin + (size_t)(r) * DM : cin + (size_t)((r) - TL) * DM)
#define NORM_LD(dst, r) do { if (first) { const float* s_ = NORM_SRC(r); _Pragma("unroll") for (int j = 0; j < 4; ++j) dst[j] = ((const f32x4*)s_)[lane + 64 * j]; } \
        else { const u32x2* s_ = (const u32x2*)(XB + (size_t)(r) * DM); _Pragma("unroll") for (int j = 0; j < 4; ++j) { const u32x2 w_ = s_[lane + 64 * j]; dst[j] = (f32x4){bflo(w_.x), bfhi(w_.x), bflo(w_.y), bfhi(w_.y)}; } } } while (0)
#define NORM_ROW(it) (router ? bidx() * tpb + wave + (it) * NWAVE : gw + (it) * NGW)
#define NORM_OK(it, r) (router ? ((it) * NWAVE < tpb) : ((r) < nrows))
    f32x4 vn[4]; f32x4 gsv[4], shv[4]; int ccur = -1;
    f32x4 rtw[16][2];
    if (router) {
#pragma unroll
        for (int j = 0; j < 4; ++j)
#pragma unroll
            for (int q = 0; q < 4; ++q) { const float* rp = A.in[I_MRT] + (size_t)(4 * lane + 256 * j + q) * 8; rtw[j * 4 + q][0] = *(const f32x4*)rp; rtw[j * 4 + q][1] = *(const f32x4*)(rp + 4); } }
    { const int r0 = NORM_ROW(0); if (NORM_OK(0, r0)) NORM_LD(vn, r0); }
    for (int it = 0;; ++it) {
        const int r = NORM_ROW(it);
        if (!NORM_OK(it, r)) break;
        const int cond = r < TL ? (r >> 13) : 4;
        f32x4 v[4];
#pragma unroll
        for (int j = 0; j < 4; ++j) v[j] = vn[j];
        { const int rn = NORM_ROW(it + 1); if (NORM_OK(it + 1, rn)) NORM_LD(vn, rn); }
        if (first) {
            if (r < TL) { const int t = r & (SEQL - 1); const f32x4* pr = (const f32x4*)(WSP(float, O_PE) + (t >> 6) * 512); const f32x4* pc = (const f32x4*)(WSP(float, O_PE) + (128 + (t & 63)) * 512);
                v[0] = v[0] + pr[lane]; v[1] = v[1] + pr[64 + lane]; v[2] = v[2] + pc[lane]; v[3] = v[3] + pc[64 + lane]; }
#pragma unroll
            for (int j = 0; j < 4; ++j) ((u32x2*)(XB + (size_t)r * DM))[lane + 64 * j] = (u32x2){pk2(v[j][0], v[j][1]), pk2(v[j][2], v[j][3])};
        }
        float ss = 0.f;
#pragma unroll
        for (int j = 0; j < 4; ++j) ss += (v[j][0] * v[j][0] + v[j][1] * v[j][1]) + (v[j][2] * v[j][2] + v[j][3] * v[j][3]);
        const float rstd = 1.0f / sqrtf(wave_sum(ss) * (1.0f / DM) + EPS);
        if (cond != ccur) { ccur = cond; const float* mp = WSP(float, O_MODS) + (size_t)(l * 5 + cond) * 6144 + which * 3072;
#pragma unroll
            for (int j = 0; j < 4; ++j) { const f32x4 g = ((const f32x4*)gp)[lane + 64 * j], sh = ((const f32x4*)mp)[lane + 64 * j], sc = ((const f32x4*)(mp + 1024))[lane + 64 * j]; gsv[j] = g * (sc + 1.0f); shv[j] = sh; } }
#pragma unroll
        for (int j = 0; j < 4; ++j) {
            v[j] = v[j] * rstd * gsv[j] + shv[j];
            if (which) ((unsigned*)((unsigned char*)H + (size_t)r * DM))[lane + 64 * j] = pack4_fp8(v[j][0], v[j][1], v[j][2], v[j][3]);
            else ((u32x2*)(H + (size_t)r * DM))[lane + 64 * j] = (u32x2){pk2(v[j][0], v[j][1]), pk2(v[j][2], v[j][3])}; }
        if (router) {
            float lg[8];
#pragma unroll
            for (int e = 0; e < 8; ++e) lg[e] = 0.f;
#pragma unroll
            for (int j = 0; j < 4; ++j)
#pragma unroll
                for (int q = 0; q < 4; ++q) { const f32x4 r0 = rtw[j * 4 + q][0], r1 = rtw[j * 4 + q][1]; const float xv = v[j][q];
                    lg[0] += xv * r0[0]; lg[1] += xv * r0[1]; lg[2] += xv * r0[2]; lg[3] += xv * r0[3]; lg[4] += xv * r1[0]; lg[5] += xv * r1[1]; lg[6] += xv * r1[2]; lg[7] += xv * r1[3]; }
#pragma unroll
            for (int e = 0; e < 8; ++e) lg[e] = wave_sum(lg[e]) + A.in[I_MRB][e];
            int e1 = 0; float v1 = lg[0];
#pragma unroll
            for (int e = 1; e < 8; ++e) if (lg[e] > v1) { v1 = lg[e]; e1 = e; }
            int e2 = -1; float v2 = -3.0e38f;
#pragma unroll
            for (int e = 0; e < 8; ++e) if (e != e1 && lg[e] > v2) { v2 = lg[e]; e2 = e; }
            const float w1 = 1.0f / (1.0f + expf(v2 - v1)), w2 = 1.0f - w1;
            if (lane == 0) { WSP(u32x4, O_TOKI)[r] = (u32x4){(unsigned)e1, (unsigned)e2, __float_as_uint(w1), __float_as_uint(w2)};
                __hip_atomic_fetch_add(sCnt + e1, 1u, __ATOMIC_RELAXED, __HIP_MEMORY_SCOPE_WORKGROUP); __hip_atomic_fetch_add(sCnt + 8 + e2, 1u, __ATOMIC_RELAXED, __HIP_MEMORY_SCOPE_WORKGROUP); }
        }
    }
    if (router) { __syncthreads(); if (tid < 16) WSP(unsigned, O_CTL)[CW_BLK + bidx() * 16 + tid] = sCnt[tid]; }
}

#ifndef ATOMIC_RESID
#define ATOMIC_RESID 0
#endif
using pg8::Unit;
struct EpiInProj {
    static constexpr bool PERM = true;
    bf16* PM; unsigned char* SG8; bf16* GDN; bf16* UH;
    __device__ __forceinline__ void operator()(const f32x4 (&acc)[2][2][4][2], const Unit& u, int wr, int wc, int fr, int fq) const {
        const int row0 = u.pm * 256 + wr * 64 + fr, cc0 = wc * 32 + 8 * fq;
#pragma unroll
        for (int ai = 0; ai < 2; ++ai)
#pragma unroll
            for (int m = 0; m < 4; ++m) { const int row = row0 + ai * 128 + m * 16;
#pragma unroll
                for (int bj = 0; bj < 2; ++bj) { const f32x4 v0 = acc[ai][bj][m][0], v1 = acc[ai][bj][m][1]; const int cc = cc0 + bj * 128;
                    if (u.pn >= 10 && u.pn < 26) { unsigned q[8];
#pragma unroll
                        for (int e = 0; e < 4; ++e) { q[e] = (unsigned)(sigmoid_fast(v0[e]) * 255.0f + 0.5f); q[4 + e] = (unsigned)(sigmoid_fast(v1[e]) * 255.0f + 0.5f); }
                        *(u32x2*)(SG8 + (size_t)row * SGC + (u.pn - 10) * 256 + cc) = (u32x2){q[0] | (q[1] << 8) | (q[2] << 16) | (q[3] << 24), q[4] | (q[5] << 8) | (q[6] << 16) | (q[7] << 24)}; }
                    else { u32x4 w; w.x = pg8::cvt_pk_bf16(v0[0], v0[1]); w.y = pg8::cvt_pk_bf16(v0[2], v0[3]); w.z = pg8::cvt_pk_bf16(v1[0], v1[1]); w.w = pg8::cvt_pk_bf16(v1[2], v1[3]);
                        if (u.pn == 4) { const int g = cc >> 4, h0 = cc & 15; *(u32x4*)(UH + ((size_t)(g * 768 + (row >> 6)) * 1280 + (row & 63) * 16 + h0)) = w; }
                        else if (u.pn < 10) *(u32x4*)(PM + (size_t)row * PMC + u.pn * 256 + cc) = w;
                        else if (cc < 32) *(u32x4*)(GDN + (size_t)row * 32 + cc) = w; } } }
    }
};
struct EpiF32 {
    static constexpr bool PERM = false;
    float* C; int ldc;
    __device__ __forceinline__ void operator()(const f32x4 (&acc)[2][2][4][2], const Unit& u, int wr, int wc, int fr, int fq) const {
        const int row0 = u.pa * 256 + wr * 64 + fr, col0 = u.pn * 256 + wc * 32 + 4 * fq;
#pragma unroll
        for (int ai = 0; ai < 2; ++ai)
#pragma unroll
            for (int m = 0; m < 4; ++m) { float* rowp = C + (size_t)(row0 + ai * 128 + m * 16) * ldc + col0;
#pragma unroll
                for (int bj = 0; bj < 2; ++bj)
#pragma unroll
                    for (int n = 0; n < 2; ++n) *(f32x4*)(rowp + bj * 128 + n * 16) = acc[ai][bj][m][n]; }
    }
};
struct EpiS5Y {
    static constexpr bool PERM = true;
    bf16* GB;
    __device__ __forceinline__ void operator()(const f32x4 (&acc)[2][2][4][2], const Unit& u, int wr, int wc, int fr, int fq) const {
        const int n0 = u.pm * 256 + wr * 64 + fr, g = u.aux;
#pragma unroll
        for (int ai = 0; ai < 2; ++ai)
#pragma unroll
            for (int m = 0; m < 4; ++m) { const int n = n0 + ai * 128 + m * 16; if (n < NCHK) {
#pragma unroll
                for (int bj = 0; bj < 2; ++bj) { const int jp = u.pn * 16 + 8 * bj + 2 * wc + (fq >> 1), h0 = 8 * (fq & 1);
                    const f32x4 v0 = acc[ai][bj][m][0], v1 = acc[ai][bj][m][1];
                    u32x4 w; w.x = pk2(gelu_tanh_fast(v0[0]), gelu_tanh_fast(v0[1])); w.y = pk2(gelu_tanh_fast(v0[2]), gelu_tanh_fast(v0[3])); w.z = pk2(gelu_tanh_fast(v1[0]), gelu_tanh_fast(v1[1])); w.w = pk2(gelu_tanh_fast(v1[2]), gelu_tanh_fast(v1[3]));
                    *(u32x4*)(GB + (size_t)(n * 64 + jp) * 256 + g * 16 + h0) = w; } } }
    }
};
struct EpiGlu {
    static constexpr bool PERM = true;
    const bf16* GB; bf16* O; const float* bias;
    __device__ __forceinline__ void operator()(const f32x4 (&acc)[2][2][4][2], const Unit& u, int wr, int wc, int fr, int fq) const {
        const int row0 = u.pm * 256 + wr * 64 + fr, cc0 = wc * 32 + 8 * fq;
#pragma unroll
        for (int ai = 0; ai < 2; ++ai)
#pragma unroll
            for (int bj = 0; bj < 2; ++bj) { const int cc = cc0 + bj * 128; u32x4 gwv[4];
                const f32x4 b0 = *(const f32x4*)(bias + cc), b1 = *(const f32x4*)(bias + cc + 4);
#pragma unroll
                for (int m = 0; m < 4; ++m) gwv[m] = *(const u32x4*)(GB + (size_t)(row0 + ai * 128 + m * 16) * 256 + cc);
#pragma unroll
                for (int m = 0; m < 4; ++m) { const int row = row0 + ai * 128 + m * 16; const u32x4 gw = gwv[m];
                    const f32x4 v0 = acc[ai][bj][m][0] + b0, v1 = acc[ai][bj][m][1] + b1;
                    u32x4 w; w.x = pk2(bflo(gw.x) * sigmoid_fast(v0[0]), bfhi(gw.x) * sigmoid_fast(v0[1])); w.y = pk2(bflo(gw.y) * sigmoid_fast(v0[2]), bfhi(gw.y) * sigmoid_fast(v0[3]));
                    w.z = pk2(bflo(gw.z) * sigmoid_fast(v1[0]), bfhi(gw.z) * sigmoid_fast(v1[1])); w.w = pk2(bflo(gw.w) * sigmoid_fast(v1[2]), bfhi(gw.w) * sigmoid_fast(v1[3]));
                    *(u32x4*)(O + (size_t)row * 256 + cc) = w; }
                asm volatile("" ::: "memory"); }
    }
};
struct EpiMerge {
    static constexpr bool PERM = false;
    const bf16* SG; float* YMF; bf16* YB;
    __device__ __forceinline__ void operator()(const f32x4 (&acc)[2][2][4][2], const Unit& u, int wr, int wc, int fr, int fq) const {
        const int row0 = u.pm * 256 + wr * 64 + fr, col0 = u.pn * 256 + wc * 32 + 4 * fq, k = u.aux;
#pragma unroll
        for (int ai = 0; ai < 2; ++ai)
#pragma unroll
            for (int m = 0; m < 4; ++m) { const int row = row0 + ai * 128 + m * 16;
#pragma unroll
                for (int bj = 0; bj < 2; ++bj)
#pragma unroll
                    for (int n = 0; n < 2; ++n) { const int col = col0 + bj * 128 + n * 16; const u32x2 sg = *(const u32x2*)(SG + (size_t)row * SGC + k * 1024 + col);
                        f32x4 v = acc[ai][bj][m][n]; v[0] *= bflo(sg.x); v[1] *= bfhi(sg.x); v[2] *= bflo(sg.y); v[3] *= bfhi(sg.y);
                        float* yp = YMF + (size_t)row * DM + col;
                        if (k > 0) v = v + *(const f32x4*)yp;
                        if (k < 3) *(f32x4*)yp = v; else *(u32x2*)(YB + (size_t)row * DM + col) = (u32x2){pk2(v[0], v[1]), pk2(v[2], v[3])}; }
                asm volatile("" ::: "memory"); }
    }
};
struct EpiResid {
    static constexpr bool PERM = true;
    bf16* X; const float* gate; float sc;
    __device__ __forceinline__ void operator()(const f32x4 (&acc)[2][2][4][2], const Unit& u, int wr, int wc, int fr, int fq) const {
        const int cond = u.pm < 128 ? (u.pm >> 5) : 4; bf16* xb = X + (size_t)u.pm * 256 * DM;
        const int row0 = wr * 64 + fr, col0 = u.pn * 256 + wc * 32 + 8 * fq; const float* gp = gate + cond * 6144 + col0;
        f32x4 gv[2][2];
#pragma unroll
        for (int bj = 0; bj < 2; ++bj) { gv[bj][0] = *(const f32x4*)(gp + bj * 128) * sc; gv[bj][1] = *(const f32x4*)(gp + bj * 128 + 4) * sc; }
#pragma unroll
        for (int ai = 0; ai < 2; ++ai) {
            u32x4 xv[4][2];
#pragma unroll
            for (int m = 0; m < 4; ++m)
#pragma unroll
                for (int bj = 0; bj < 2; ++bj) xv[m][bj] = *(const u32x4*)(xb + (size_t)(row0 + ai * 128 + m * 16) * DM + col0 + bj * 128);
#pragma unroll
            for (int m = 0; m < 4; ++m)
#pragma unroll
                for (int bj = 0; bj < 2; ++bj) { const f32x4 v0 = gv[bj][0] * acc[ai][bj][m][0], v1 = gv[bj][1] * acc[ai][bj][m][1]; const u32x4 x = xv[m][bj]; u32x4 o;
                    o.x = pk2(bflo(x.x) + v0[0], bfhi(x.x) + v0[1]); o.y = pk2(bflo(x.y) + v0[2], bfhi(x.y) + v0[3]); o.z = pk2(bflo(x.z) + v1[0], bfhi(x.z) + v1[1]); o.w = pk2(bflo(x.w) + v1[2], bfhi(x.w) + v1[3]);
                    *(u32x4*)(xb + (size_t)(row0 + ai * 128 + m * 16) * DM + col0 + bj * 128) = o; }
            asm volatile("" ::: "memory"); }
    }
};
struct EpiSwiGLU {
    static constexpr bool PERM = true;
    bf16* O; int ldo;
    __device__ __forceinline__ void operator()(const f32x4 (&acc)[2][2][4][2], const Unit& u, int wr, int wc, int fr, int fq) const {
        const int row0 = u.pm * 256 + wr * 64 + fr, col0 = u.pn * 128 + wc * 32 + 8 * fq;
#pragma unroll
        for (int ai = 0; ai < 2; ++ai)
#pragma unroll
            for (int m = 0; m < 4; ++m) { float o[8];
#pragma unroll
                for (int n = 0; n < 2; ++n)
#pragma unroll
                    for (int e = 0; e < 4; ++e) { const float gg = acc[ai][0][m][n][e], uu = acc[ai][1][m][n][e]; o[n * 4 + e] = gg * sigmoid_fast(gg) * uu; }
                u32x4 w; w.x = pg8::cvt_pk_bf16(o[0], o[1]); w.y = pg8::cvt_pk_bf16(o[2], o[3]); w.z = pg8::cvt_pk_bf16(o[4], o[5]); w.w = pg8::cvt_pk_bf16(o[6], o[7]);
                *(u32x4*)(O + (size_t)(row0 + ai * 128 + m * 16) * ldo + col0) = w; }
    }
};
struct EpiSwiGLU8 {
    static constexpr bool PERM = true;
    unsigned char* O; int ldo;
    __device__ __forceinline__ void operator()(const f32x4 (&acc)[2][2][4][2], const Unit& u, int wr, int wc, int fr, int fq) const {
        const int row0 = u.pm * 256 + wr * 64 + fr, col0 = u.pn * 128 + wc * 32 + 8 * fq;
#pragma unroll
        for (int ai = 0; ai < 2; ++ai)
#pragma unroll
            for (int m = 0; m < 4; ++m) { float o[8];
#pragma unroll
                for (int n = 0; n < 2; ++n)
#pragma unroll
                    for (int e = 0; e < 4; ++e) { const float gg = acc[ai][0][m][n][e] * 0.03125f, uu = acc[ai][1][m][n][e] * 0.125f; o[n * 4 + e] = gg * sigmoid_fast(gg) * uu; }
                *(u32x2*)(O + (size_t)(row0 + ai * 128 + m * 16) * ldo + col0) = (u32x2){pack4_fp8(o[0], o[1], o[2], o[3]), pack4_fp8(o[4], o[5], o[6], o[7])}; }
    }
};
struct EpiMoeDown {
    static constexpr bool PERM = false;
    float* XL; const float* gate; const int* rtok; const float* rw; float sc;
    __device__ __forceinline__ void operator()(const f32x4 (&acc)[2][2][4][2], const Unit& u, int wr, int wc, int fr, int fq) const {
        const int row0 = u.pm * 256 + wr * 64 + fr, col0 = u.pn * 256 + wc * 32 + 4 * fq;
#pragma unroll
        for (int ai = 0; ai < 2; ++ai) { int tok[4]; float w[4];
#pragma unroll
            for (int m = 0; m < 4; ++m) { const int row = row0 + ai * 128 + m * 16; tok[m] = rtok[row]; w[m] = rw[row] * sc; }
            f32x4 xv[4][2][2];
            if (!u.split && !ATOMIC_RESID) {
#pragma unroll
                for (int m = 0; m < 4; ++m) if (tok[m] >= 0) {
#pragma unroll
                    for (int bj = 0; bj < 2; ++bj)
#pragma unroll
                        for (int n = 0; n < 2; ++n) xv[m][bj][n] = *(const f32x4*)(XL + (size_t)tok[m] * DM + col0 + bj * 128 + n * 16); } }
#pragma unroll
            for (int m = 0; m < 4; ++m) if (tok[m] >= 0) { const float* gp = gate + (tok[m] >> 13) * 6144 + col0; float* rowp = XL + (size_t)tok[m] * DM + col0;
#pragma unroll
                for (int bj = 0; bj < 2; ++bj)
#pragma unroll
                    for (int n = 0; n < 2; ++n) { float* p = rowp + bj * 128 + n * 16; const f32x4 gv = *(const f32x4*)(gp + bj * 128 + n * 16); const f32x4 v = gv * w[m] * acc[ai][bj][m][n];
                        if (u.split || ATOMIC_RESID) { unsafeAtomicAdd(p, v[0]); unsafeAtomicAdd(p + 1, v[1]); unsafeAtomicAdd(p + 2, v[2]); unsafeAtomicAdd(p + 3, v[3]); } else *(f32x4*)p = xv[m][bj][n] + v; } }
            asm volatile("" ::: "memory"); }
    }
};
struct EpiMoeDelta {
    static constexpr bool PERM = true;
    bf16* D; const float* gate; const int* rtok; const float* rw; float sc;
    __device__ __forceinline__ void operator()(const f32x4 (&acc)[2][2][4][2], const Unit& u, int wr, int wc, int fr, int fq) const {
        const int row0 = u.pm * 256 + wr * 64 + fr, col0 = u.pn * 256 + wc * 32 + 8 * fq;
        int tok[2][4]; float w[2][4];
#pragma unroll
        for (int ai = 0; ai < 2; ++ai)
#pragma unroll
            for (int m = 0; m < 4; ++m) { const int row = row0 + ai * 128 + m * 16; tok[ai][m] = rtok[row]; w[ai][m] = rw[row] * sc; }
#pragma unroll
        for (int ai = 0; ai < 2; ++ai)
#pragma unroll
            for (int bj = 0; bj < 2; ++bj) { f32x4 g0[4], g1[4];
#pragma unroll
                for (int m = 0; m < 4; ++m) { const float* gp = gate + (max(tok[ai][m], 0) >> 13) * 6144 + col0 + bj * 128; g0[m] = *(const f32x4*)gp; g1[m] = *(const f32x4*)(gp + 4); }
#pragma unroll
                for (int m = 0; m < 4; ++m) if (tok[ai][m] >= 0) { const int row = row0 + ai * 128 + m * 16; const f32x4 v0 = acc[ai][bj][m][0] * g0[m] * w[ai][m], v1 = acc[ai][bj][m][1] * g1[m] * w[ai][m];
                    u32x4 o; o.x = pg8::cvt_pk_bf16(v0[0], v0[1]); o.y = pg8::cvt_pk_bf16(v0[2], v0[3]); o.z = pg8::cvt_pk_bf16(v1[0], v1[1]); o.w = pg8::cvt_pk_bf16(v1[2], v1[3]);
                    *(u32x4*)(D + (size_t)row * DM + col0 + bj * 128) = o; }
                asm volatile("" ::: "memory"); }
    }
};
struct OneUnit { bool has; Unit u; __device__ bool next(int i, Unit& o) const { if (i == 0 && has) { o = u; o.k0 = 0; o.nkt = 0; o.split = 0; return true; } return false; } };

struct MoeOrder { int G, c, nN, ntile, pa0; int tb[9];
    __device__ bool next(int i, Unit& u) const { const int L = i * G + c; if (L >= ntile * nN) return false; const int pm = L / nN, pn = L % nN; int e = 0;
#pragma unroll
        for (int q = 1; q < 8; ++q) e += (pm >= tb[q]) ? 1 : 0;
        u.pm = pm; u.pn = pn; u.pa = pa0 + pm; u.pb = e * nN + pn; u.aux = e; u.k0 = 0; u.nkt = 0; u.split = 0; return true; } };
struct Moe2Order { int G, c, nN; int tb0[9], tb1[9];
    __device__ bool next(int i, Unit& u) const { const int T0 = tb0[8], T1 = tb1[8]; const int L = i * G + c; if (L >= (T0 + T1) * nN) return false; const int pg = L / nN, pn = L - pg * nN; const int s = pg >= T0 ? 1 : 0, pl = pg - (s ? T0 : 0); int e = 0;
#pragma unroll
        for (int q = 1; q < 8; ++q) e += (pl >= (s ? tb1[q] : tb0[q])) ? 1 : 0;
        u.pa = s * (MOE_ROWS / 256) + pl; u.pm = u.pa; u.pn = pn; u.pb = e * nN + pn; u.aux = e; u.k0 = 0; u.nkt = 0; u.split = 0; return true; } };
struct SplitOrder { int G, c, U, KT, pa0, moe, smax; int tb[9];
    __device__ bool next(int i, Unit& u) const { const int R = U / G, rem = U - R * G; int S = 1; if (rem > 0 && rem * 2 <= G) { S = G / rem; if (S > smax) S = smax; if (S > KT / 2) S = KT / 2; }
        int L, part = 0; if (i < R) L = i * G + c; else if (i == R && c < rem * S) { L = R * G + c / S; part = c - (c / S) * S; } else return false;
        const int pm = L >> 2, pn = L & 3; int e = 0;
        if (moe) {
#pragma unroll
            for (int q = 1; q < 8; ++q) e += (pm >= tb[q]) ? 1 : 0; }
        u.pm = pm; u.pn = pn; u.pa = pa0 + pm; u.pb = e * 4 + pn; u.aux = e;
        if (i == R && S > 1) { const int pairs = KT / 2, p0 = (part * pairs) / S, p1 = ((part + 1) * pairs) / S; u.k0 = 2 * p0; u.nkt = 2 * (p1 - p0); u.split = 1; } else { u.k0 = 0; u.nkt = 0; u.split = 0; }
        return true; } };

__device__ __forceinline__ void s5_tables(CArgs& A) {
    f32x2* PW = WSP(f32x2, O_S5PW); f32x2* Q = WSP(f32x2, O_S5Q);
    for (int i = bidx() * NTHR + tidx(); i < 2 * 16 * 2 * 65 * 64; i += gdim() * NTHR) {
        const int p = i & 63, e = (i >> 6) % 65, lgd = i / (65 * 64), d = lgd & 1, g = (lgd >> 1) & 15, l = lgd >> 5; const int pb = (l * 2 + d) * 16 + g;
        const double dt = exp((double)A.in[I_LDT][pb]); const double lre = fmin((double)A.in[I_LRE][pb * 64 + p], -1e-4), lim = (double)A.in[I_LIM][pb * 64 + p];
        const double mag = exp(lre * dt * e); double sn, cs; sincos(lim * dt * e, &sn, &cs);
        PW[i] = (f32x2){(float)(mag * cs), (float)(mag * sn)};
        if (e == 1) { const double nr = mag * cs - 1.0, ni = mag * sn, den = lre * lre + lim * lim; Q[lgd * 64 + p] = (f32x2){(float)((nr * lre + ni * lim) / den), (float)((ni * lre - nr * lim) / den)}; }
    }
}
__device__ __forceinline__ void s5_ktable_unit(CArgs& A, LAS unsigned char* lds, int uq) {
    const int tid = tidx(); LAS float* sK = (LAS float*)lds;
    LAS double* sL = (LAS double*)(lds + 16384);
    LAS float* sB = (LAS float*)(lds + 20480);
    LAS float* sC = (LAS float*)(lds + 28672);
    const int mq = uq & 3, u = uq >> 2, d = u & 1, g = (u >> 1) & 15, l = u >> 5, pb = (l * 2 + d) * 16 + g; const int ph = tid >> 8, hp = (tid >> 4) & 15, h = tid & 15;
    for (int i = tid; i < 1024; i += NTHR) { sB[i] = A.in[I_BRE][pb * 1024 + i]; sB[1024 + i] = A.in[I_BIM][pb * 1024 + i];
        const int r = i >> 6, c = i & 63; sC[r * 65 + c] = A.in[I_CRE][pb * 1024 + i]; sC[1040 + r * 65 + c] = A.in[I_CIM][pb * 1024 + i]; }
    if (tid < 64) { const int p = tid; const double dt = exp((double)A.in[I_LDT][pb]);
        const double lre = fmin((double)A.in[I_LRE][pb * 64 + p], -1e-4), lim = (double)A.in[I_LIM][pb * 64 + p];
        const double er = exp(lre * dt); double sn, cs; sincos(lim * dt, &sn, &cs); const double lbr = er * cs, lbi = er * sn;
        const double nr = lbr - 1.0, ni = lbi, den = lre * lre + lim * lim; const double qr = (nr * lre + ni * lim) / den, qi = (ni * lre - nr * lim) / den;
        const double e0 = (double)(16 * mq); const double er0 = exp(lre * dt * e0); double sn0, cs0; sincos(lim * dt * e0, &sn0, &cs0);
        sL[p * 6 + 0] = lbr; sL[p * 6 + 1] = lbi; sL[p * 6 + 2] = qr; sL[p * 6 + 3] = qi; sL[p * 6 + 4] = er0 * cs0; sL[p * 6 + 5] = er0 * sn0; }
    __syncthreads();
    float acc[16];
#pragma unroll
    for (int m = 0; m < 16; ++m) acc[m] = 0.f;
    for (int p = ph * 32; p < ph * 32 + 32; ++p) {
        const double lbr = sL[p * 6 + 0], lbi = sL[p * 6 + 1], qr = sL[p * 6 + 2], qi = sL[p * 6 + 3], pr = sL[p * 6 + 4], pi = sL[p * 6 + 5];
        const double br_ = (double)sB[p * 16 + h], bi_ = (double)sB[1024 + p * 16 + h];
        const double bbr = qr * br_ - qi * bi_, bbi = qr * bi_ + qi * br_;
        const double cr = (double)sC[hp * 65 + p], ci = (double)sC[1040 + hp * 65 + p];
        const double c0r = cr * bbr - ci * bbi, c0i = cr * bbi + ci * bbr;
        float cur_r = (float)(c0r * pr - c0i * pi), cur_i = (float)(c0r * pi + c0i * pr); const float wr_ = (float)lbr, wi_ = (float)lbi;
#pragma unroll
        for (int m = 0; m < 16; ++m) { acc[m] += cur_r; const float t = cur_r * wr_ - cur_i * wi_; cur_i = cur_r * wi_ + cur_i * wr_; cur_r = t; }
    }
    if (ph == 1) {
#pragma unroll
        for (int m = 0; m < 16; ++m) sK[m * 256 + hp * 16 + h] = acc[m]; }
    __syncthreads();
    if (ph == 0) { float* KT = WSP(float, O_S5K) + ((size_t)u * 64 + mq * 16) * 256;
#pragma unroll
        for (int m = 0; m < 16; ++m) KT[m * 256 + hp * 16 + h] = acc[m] + sK[m * 256 + hp * 16 + h]; }
    __syncthreads();
}
__device__ __forceinline__ void s5_fill_unit(CArgs& A, int l, int u) {
    const int tid = tidx(), g = u >> 4, sl = u & 15;
    const float* KF = WSP(float, O_S5K) + (size_t)(((l * 16 + g) * 2 + 0)) * 64 * 256; const float* KB = KF + 64 * 256;
    const f32x2* PW = WSP(f32x2, O_S5PW) + (size_t)((l * 16 + g) * 2) * 65 * 64; const f32x2* Q = WSP(f32x2, O_S5Q) + (size_t)((l * 16 + g) * 2) * 64;
    bf16* TC = WSP(bf16, O_TCM) + (size_t)g * 1024 * 1280;
    for (int idx = tid; idx < 64 * 128; idx += NTHR) { const int row = sl * 64 + (idx >> 7), cg = idx & 127, jp = row >> 4, hp = row & 15, j = cg >> 1, h0 = (cg & 1) * 8; float v[8];
        if (jp != j) { const float* kp = (jp > j ? KF + (jp - j) * 256 : KB + (j - jp) * 256) + hp * 16 + h0; const f32x4 a = *(const f32x4*)kp, b = *(const f32x4*)(kp + 4);
            v[0] = a[0]; v[1] = a[1]; v[2] = a[2]; v[3] = a[3]; v[4] = b[0]; v[5] = b[1]; v[6] = b[2]; v[7] = b[3]; }
        else {
#pragma unroll
            for (int e = 0; e < 8; ++e) { const int h = h0 + e; v[e] = KF[hp * 16 + h] + KB[hp * 16 + h] + (hp == h ? A.in[I_S5D][(l * 16 + g) * 16 + h] : 0.f); } }
        *(u32x4*)(TC + (size_t)row * 1280 + j * 16 + h0) = (u32x4){pk2(v[0], v[1]), pk2(v[2], v[3]), pk2(v[4], v[5]), pk2(v[6], v[7])}; }
    for (int idx = tid; idx < 64 * 16; idx += NTHR) { const int p0 = (idx & 7) * 8, d = (idx >> 3) & 1, row = sl * 64 + (idx >> 4), jp = row >> 4, hp = row & 15;
        const int e = d == 0 ? jp + 1 : 64 - jp; const int pb = (l * 2 + d) * 16 + g;
        const f32x4* wp = (const f32x4*)(PW + (d * 65 + e) * 64 + p0); const f32x4 w01 = wp[0], w23 = wp[1], w45 = wp[2], w67 = wp[3];
        const float* crp = A.in[I_CRE] + (size_t)(pb * 16 + hp) * 64 + p0; const float* cip = A.in[I_CIM] + (size_t)(pb * 16 + hp) * 64 + p0;
        const f32x4 cr0 = *(const f32x4*)crp, cr1 = *(const f32x4*)(crp + 4), ci0 = *(const f32x4*)cip, ci1 = *(const f32x4*)(cip + 4);
        const float wx[8] = {w01[0], w01[2], w23[0], w23[2], w45[0], w45[2], w67[0], w67[2]}, wy[8] = {w01[1], w01[3], w23[1], w23[3], w45[1], w45[3], w67[1], w67[3]};
        const float cr[8] = {cr0[0], cr0[1], cr0[2], cr0[3], cr1[0], cr1[1], cr1[2], cr1[3]}, ci[8] = {ci0[0], ci0[1], ci0[2], ci0[3], ci1[0], ci1[1], ci1[2], ci1[3]};
        float re[8], im[8];
#pragma unroll
        for (int k = 0; k < 8; ++k) { re[k] = cr[k] * wx[k] - ci[k] * wy[k]; im[k] = -(cr[k] * wy[k] + ci[k] * wx[k]); }
        bf16* o = TC + (size_t)row * 1280 + 1024 + d * 128 + p0;
        *(u32x4*)o = (u32x4){pk2(re[0], re[1]), pk2(re[2], re[3]), pk2(re[4], re[5]), pk2(re[6], re[7])};
        *(u32x4*)(o + 64) = (u32x4){pk2(im[0], im[1]), pk2(im[2], im[3]), pk2(im[4], im[5]), pk2(im[6], im[7])}; }
    bf16* BP = WSP(bf16, O_BPOW) + (size_t)g * 256 * 1024;
    for (int idx = tid; idx < 16 * 128; idx += NTHR) { const int h0 = (idx & 1) * 8, j = (idx >> 1) & 63, row = sl * 16 + (idx >> 7), d = row >> 7, ri = (row >> 6) & 1, p = row & 63;
        const int e = d == 0 ? 63 - j : j; const f32x2 w = PW[(d * 65 + e) * 64 + p], q = Q[d * 64 + p]; const int pb = (l * 2 + d) * 16 + g;
        const float* brp = A.in[I_BRE] + (size_t)(pb * 64 + p) * 16 + h0; const float* bip = A.in[I_BIM] + (size_t)(pb * 64 + p) * 16 + h0;
        const f32x4 br0 = *(const f32x4*)brp, br1 = *(const f32x4*)(brp + 4), bi0 = *(const f32x4*)bip, bi1 = *(const f32x4*)(bip + 4);
        const float br[8] = {br0[0], br0[1], br0[2], br0[3], br1[0], br1[1], br1[2], br1[3]}, bi[8] = {bi0[0], bi0[1], bi0[2], bi0[3], bi1[0], bi1[1], bi1[2], bi1[3]};
        float v[8];
#pragma unroll
        for (int k = 0; k < 8; ++k) { const float bbr = q.x * br[k] - q.y * bi[k], bbi = q.x * bi[k] + q.y * br[k]; v[k] = ri == 0 ? (w.x * bbr - w.y * bbi) : (w.x * bbi + w.y * bbr); }
        *(u32x4*)(BP + (size_t)row * 1024 + j * 16 + h0) = (u32x4){pk2(v[0], v[1]), pk2(v[2], v[3]), pk2(v[4], v[5]), pk2(v[6], v[7])}; }
}

constexpr int GT = 72;
__device__ __forceinline__ u32x4 pack8(const float (&v)[8]) { return (u32x4){pk2(v[0], v[1]), pk2(v[2], v[3]), pk2(v[4], v[5]), pk2(v[6], v[7])}; }
template <int D>
__device__ __forceinline__ void gla_prep_a(CArgs& A, int l, int hd, const LAS float* sG, LAS float* sGs, int lane, int jg, float (&c)[8]) {
    float wu[16];
#pragma unroll
    for (int r = 0; r < 16; ++r) wu[r] = A.in[I_GWUP][((l * 2 + D) * 16 + r) * 256 + hd * 64 + lane];
    const float bu = A.in[I_GBUP][(l * 2 + D) * 256 + hd * 64 + lane];
#pragma unroll
    for (int i = 0; i < 8; ++i) { const int j = jg * 8 + i; float z = bu;
#pragma unroll
        for (int r = 0; r < 16; ++r) z += sG[j * 32 + 16 * D + r] * wu[r];
        c[i] = (fminf(z, 0.f) - __logf(1.0f + __expf(-fabsf(z)))) * 0.0625f; }
    if (D == 0) {
#pragma unroll
        for (int i = 1; i < 8; ++i) c[i] += c[i - 1]; }
    else {
#pragma unroll
        for (int i = 6; i >= 0; --i) c[i] += c[i + 1]; }
    sGs[(D * 8 + jg) * 64 + lane] = D == 0 ? c[7] : c[0];
}
template <int D>
__device__ __forceinline__ void gla_prep_b(const LAS float* sGs, int lane, int jg, float (&c)[8], float& tot) {
    float off = 0.f, t = 0.f;
#pragma unroll
    for (int g = 0; g < 8; ++g) { const float v = sGs[(D * 8 + g) * 64 + lane]; t += v; off += (D == 0 ? (g < jg) : (g > jg)) ? v : 0.f; }
#pragma unroll
    for (int i = 0; i < 8; ++i) c[i] += off;
    tot = t;
}
__device__ __forceinline__ void gla_load_gdn(const bf16* GDN, int r0, LAS float* sG, int tid) {
    if (tid < 256) { const int j = tid >> 2, seg = tid & 3; const u32x4 w = *(const u32x4*)(GDN + (size_t)(r0 + j) * 32 + seg * 8); LAS float* o = sG + j * 32 + seg * 8;
        o[0] = bflo(w.x); o[1] = bfhi(w.x); o[2] = bflo(w.y); o[3] = bfhi(w.y); o[4] = bflo(w.z); o[5] = bfhi(w.z); o[6] = bflo(w.w); o[7] = bfhi(w.w); }
}
__device__ __forceinline__ void tile_mma(f32x16& acc, const LAS bf16* X, const LAS bf16* Y, int tm, int tn, int lane) {
    const int r = lane & 31, h = lane >> 5; const LAS bf16* xp = X + (32 * tm + r) * GT + 8 * h; const LAS bf16* yp = Y + (32 * tn + r) * GT + 8 * h;
#pragma unroll
    for (int s = 0; s < 4; ++s) { const bf16x8 a = *(const LAS bf16x8*)(xp + 16 * s), b = *(const LAS bf16x8*)(yp + 16 * s); acc = __builtin_amdgcn_mfma_f32_32x32x16_bf16(a, b, acc, 0, 0, 0); }
}
__device__ __forceinline__ void gla_local_unit(CArgs& A, LAS unsigned char* lds, int l, int n, int hd) {
    const int tid = tidx(), lane = tid & 63, jg = tid >> 6; const int r0 = n * 64;
    LAS bf16* sVT = (LAS bf16*)lds; LAS bf16* sKo = sVT + 64 * GT;
    LAS float* sG = (LAS float*)(lds + 3 * 64 * GT * 2); LAS float* sGs = sG + 2048;
    const bf16* PM = WSP(bf16, O_PM);
    gla_load_gdn(WSP(bf16, O_GDN), r0, sG, tid);
    float kv[8], vv[8];
#pragma unroll
    for (int i = 0; i < 8; ++i) { const size_t ro = (size_t)(r0 + jg * 8 + i) * PMC + hd * 64 + lane; kv[i] = bf2f(PM[ro + 256]); vv[i] = bf2f(PM[ro + 512]); }
    *(LAS u32x4*)(sVT + lane * GT + 8 * jg) = pack8(vv);
    __syncthreads();
    float* DEC = WSP(float, O_GDEC);
    float c0[8], c1[8], tot0, tot1;
    gla_prep_a<0>(A, l, hd, sG, sGs, lane, jg, c0); gla_prep_a<1>(A, l, hd, sG, sGs, lane, jg, c1);
    __syncthreads();
    gla_prep_b<0>(sGs, lane, jg, c0, tot0); gla_prep_b<1>(sGs, lane, jg, c1, tot1);
    { const float (&c)[8] = c0; const float tot = tot0; float ko[8];
#pragma unroll
      for (int i = 0; i < 8; ++i) ko[i] = kv[i] * __expf(tot - c[i]);
      *(LAS u32x4*)(sKo + lane * GT + 8 * jg) = pack8(ko); if (jg == 0) DEC[((hd * 2 + 0) * NCHK + n) * 64 + lane] = __expf(tot); }
    { const float (&c)[8] = c1; const float tot = tot1; float ko[8];
#pragma unroll
      for (int i = 0; i < 8; ++i) ko[i] = kv[i] * __expf(tot - c[i]);
      *(LAS u32x4*)(sKo + 64 * GT + lane * GT + 8 * jg) = pack8(ko); if (jg == 0) DEC[((hd * 2 + 1) * NCHK + n) * 64 + lane] = __expf(tot); }
    __syncthreads();
    { const int d = jg >> 2, tm = (jg >> 1) & 1, tn = jg & 1; f32x16 acc;
#pragma unroll
      for (int i = 0; i < 16; ++i) acc[i] = 0.f;
      tile_mma(acc, sVT, sKo + d * 64 * GT, tm, tn, lane);
      float* sp = WSP(float, O_H) + ((size_t)((hd * 2 + d) * NCHK + n)) * 4096 + 32 * tn + (lane & 31);
#pragma unroll
      for (int i = 0; i < 16; ++i) { const int dv = 32 * tm + (i & 3) + 8 * (i >> 2) + 4 * (lane >> 5); sp[dv * 64] = acc[i]; } }
    __syncthreads();
}
__device__ __forceinline__ void gla_carry(CArgs& A) {
    const float* ST = WSP(float, O_H); const float* DEC = WSP(float, O_GDEC); bf16* SB = WSP(bf16, O_GS16);
    for (int e = bidx() * NTHR + tidx(); e < 131072; e += gdim() * NTHR) {
        const int dk = e & 63, el = e & 4095, chain = e >> 12, b = chain & 3, hd = (chain >> 2) & 3, d = chain >> 4; const int base = (hd * 2 + d) * NCHK;
        float s = 0.f;
        for (int st = 0; st < 132; st += 12) { float tmp[12], dec[12]; unsigned ix[12];
#pragma unroll
            for (int q = 0; q < 12; ++q) { const int n = seq_chunk(b, d, st + q); ix[q] = (unsigned)(base + n) * 4096u + (unsigned)el; tmp[q] = ST[ix[q]]; dec[q] = DEC[(base + n) * 64 + dk]; }
#pragma unroll
            for (int q = 0; q < 12; ++q) { SB[ix[q]] = (bf16)f2bf(s); s = dec[q] * s + tmp[q]; } }
    }
}
template <int D>
__device__ __forceinline__ void gla_out_prep(CArgs& A, int hd, int n, const float (&c)[8], LAS bf16* sQi, LAS bf16* sKi, LAS bf16* sST, const float (&qv)[8], const float (&kv)[8], int tid) {
    const int lane = tid & 63, jg = tid >> 6;
#pragma unroll
    for (int i = 0; i < 8; ++i) { const int j = jg * 8 + i; sQi[j * GT + lane] = (bf16)f2bf(qv[i] * 0.125f * __expf(c[i])); sKi[j * GT + lane] = (bf16)f2bf(kv[i] * __expf(-c[i])); }
    *(LAS u32x4*)(sST + (tid >> 3) * GT + (tid & 7) * 8) = *(const u32x4*)(WSP(bf16, O_GS16) + ((size_t)((hd * 2 + D) * NCHK + n)) * 4096 + tid * 8);
}
__device__ __forceinline__ void gla_out_unit(CArgs& A, LAS unsigned char* lds, int l, int n, int hd) {
    const int tid = tidx(), lane = tid & 63, jg = tid >> 6; const int r0 = n * 64;
    LAS bf16* T = (LAS bf16*)lds; constexpr int TS = 64 * GT;
    LAS float* sG = (LAS float*)(lds + 9 * TS * 2); LAS float* sGs = sG + 2048; LAS float* sO = sGs + 1024;
    const bf16* PM = WSP(bf16, O_PM);
    gla_load_gdn(WSP(bf16, O_GDN), r0, sG, tid);
    float qv[8], kv[8], vv[8]; bf16 ogr[8];
#pragma unroll
    for (int i = 0; i < 8; ++i) { const size_t ro = (size_t)(r0 + jg * 8 + i) * PMC + hd * 64 + lane; qv[i] = bf2f(PM[ro]); kv[i] = bf2f(PM[ro + 256]); vv[i] = bf2f(PM[ro + 512]); ogr[i] = PM[ro + 768]; }
    *(LAS u32x4*)(T + lane * GT + 8 * jg) = pack8(vv);
    __syncthreads();
    { float c0[8], c1[8], tot0, tot1;
      gla_prep_a<0>(A, l, hd, sG, sGs, lane, jg, c0); gla_prep_a<1>(A, l, hd, sG, sGs, lane, jg, c1);
      __syncthreads();
      gla_prep_b<0>(sGs, lane, jg, c0, tot0); gla_prep_b<1>(sGs, lane, jg, c1, tot1);
      gla_out_prep<0>(A, hd, n, c0, T + 1 * TS, T + 2 * TS, T + 4 * TS, qv, kv, tid);
      gla_out_prep<1>(A, hd, n, c1, T + 5 * TS, T + 6 * TS, T + 8 * TS, qv, kv, tid); }
    __syncthreads();
    const int d = jg >> 2, tm = (jg >> 1) & 1, tn = jg & 1, cl = lane & 31, hh = lane >> 5;
    { f32x16 acc;
#pragma unroll
      for (int i = 0; i < 16; ++i) acc[i] = 0.f;
      tile_mma(acc, T + (1 + 4 * d) * TS, T + (2 + 4 * d) * TS, tm, tn, lane);
      LAS bf16* at = T + (3 + 4 * d) * TS; const int j = 32 * tn + cl;
#pragma unroll
      for (int i = 0; i < 16; ++i) { const int ii = 32 * tm + (i & 3) + 8 * (i >> 2) + 4 * hh; const bool keep = d ? (j >= ii) : (j <= ii); at[ii * GT + j] = (bf16)f2bf(keep ? acc[i] : 0.f); } }
    __syncthreads();
    { f32x16 acc;
#pragma unroll
      for (int i = 0; i < 16; ++i) acc[i] = 0.f;
      tile_mma(acc, T + (3 + 4 * d) * TS, T, tm, tn, lane);
      tile_mma(acc, T + (1 + 4 * d) * TS, T + (4 + 4 * d) * TS, tm, tn, lane);
      const int dv = 32 * tn + cl; LAS float* so = sO + d * (64 * 65);
#pragma unroll
      for (int i = 0; i < 16; ++i) so[(32 * tm + (i & 3) + 8 * (i >> 2) + 4 * hh) * 65 + dv] = acc[i]; }
    __syncthreads();
    bf16* BR0 = WSP(bf16, O_BR);
#pragma unroll
    for (int i = 0; i < 8; ++i) { const int row = jg * 8 + i; const float o = sO[row * 65 + lane] + sO[64 * 65 + row * 65 + lane]; const float ssq = wave_sum(o * o); const float rstd = 1.0f / sqrtf(ssq * (1.0f / 64.0f) + EPS);
        const float og = bf2f(ogr[i]);
        BR0[(size_t)(r0 + row) * 256 + hd * 64 + lane] = (bf16)f2bf(o * rstd * og * sigmoid_fast(og)); }
    __syncthreads();
}

__device__ __forceinline__ void merge_unit(CArgs& A, LAS unsigned char* lds, int l, int pm, int pn) {
    const int tid = tidx(), lane = tid & 63, wave = tid >> 6, wr = wave >> 2, wc = wave & 3, fr = lane & 15, fq = lane >> 4;
    constexpr int ABYTES = 128 * GT * 2, BBYTES = 256 * GT * 2, SLOT = ABYTES + BBYTES;
    const bf16* BR = WSP(bf16, O_BR); const bf16* WB = WSP(bf16, O_WBR) + (size_t)l * 4 * 1024 * 256; const unsigned char* SG = WSP(unsigned char, O_SG);
    const int arow = tid >> 3, aseg = tid & 7;
    const bf16* ag = BR + (size_t)(pm * 128 + arow) * 256 + aseg * 8; const bf16* bg = WB + (size_t)(pn * 256 + (arow & ~31) + pg8::perm32(arow & 31)) * 256 + aseg * 8;
    u32x4 ast[2][2], bst[4];
#define MRG_LOADA(t, q) do { const int _k = (t) >> 2, _kt = (t) & 3; const bf16* _a = ag + (size_t)_k * TT * 256 + _kt * 64; ast[q][0] = *(const u32x4*)_a; ast[q][1] = *(const u32x4*)(_a + 64 * 256); } while (0)
#define MRG_LOADB(t) do { const int _k = (t) >> 2, _kt = (t) & 3; const bf16* _b = bg + (size_t)_k * 1024 * 256 + _kt * 64; \
        _Pragma("unroll") for (int _i = 0; _i < 4; ++_i) bst[_i] = *(const u32x4*)(_b + (size_t)_i * 64 * 256); } while (0)
#define MRG_STORE(slot, q) do { LAS unsigned char* _s = lds + (slot) * SLOT; \
        *(LAS u32x4*)(_s + (arow * GT + aseg * 8) * 2) = ast[q][0]; *(LAS u32x4*)(_s + ((arow + 64) * GT + aseg * 8) * 2) = ast[q][1]; \
        _Pragma("unroll") for (int _i = 0; _i < 4; ++_i) *(LAS u32x4*)(_s + ABYTES + ((arow + 64 * _i) * GT + aseg * 8) * 2) = bst[_i]; } while (0)
    f32x4 acc[4][4], ys[4][4]; u32x2 sgr[4][2];
#pragma unroll
    for (int m = 0; m < 4; ++m)
#pragma unroll
        for (int n = 0; n < 4; ++n) { acc[m][n] = (f32x4){0.f, 0.f, 0.f, 0.f}; ys[m][n] = (f32x4){0.f, 0.f, 0.f, 0.f}; }
    MRG_LOADA(0, 0); MRG_LOADB(0); MRG_LOADA(1, 1); MRG_STORE(0, 0);
    __syncthreads();
#define MRG_STEP(t, q) do {   \
        if ((t) + 2 < 16) MRG_LOADA((t) + 2, 1 - (q)); if ((t) + 1 < 16) MRG_LOADB((t) + 1); \
        if (((t) & 3) == 3) { const int k = (t) >> 2; int fr2 = fr, fq2 = fq; asm volatile("" : "+v"(fr2), "+v"(fq2)); const int row0 = pm * 128 + wr * 64 + fr2, col0 = pn * 256 + wc * 64 + 8 * fq2;     \
            _Pragma("unroll") for (int m = 0; m < 4; ++m) _Pragma("unroll") for (int j = 0; j < 2; ++j) sgr[m][j] = *(const u32x2*)(SG + (size_t)(row0 + 16 * m) * SGC + k * 1024 + col0 + 32 * j); } \
        const LAS bf16* sA = (const LAS bf16*)(lds + ((t) & 1) * SLOT) + (wr * 64 + fr) * GT + 8 * fq; const LAS bf16* sB = (const LAS bf16*)(lds + ((t) & 1) * SLOT + ABYTES) + (wc * 64 + fr) * GT + 8 * fq; \
        _Pragma("unroll") for (int s2 = 0; s2 < 2; ++s2) { bf16x8 af[4]; \
            _Pragma("unroll") for (int m = 0; m < 4; ++m) af[m] = *(const LAS bf16x8*)(sA + m * 16 * GT + 32 * s2); \
            _Pragma("unroll") for (int n = 0; n < 4; ++n) { const bf16x8 bfg = *(const LAS bf16x8*)(sB + n * 16 * GT + 32 * s2); \
                _Pragma("unroll") for (int m = 0; m < 4; ++m) acc[m][n] = __builtin_amdgcn_mfma_f32_16x16x32_bf16(bfg, af[m], acc[m][n], 0, 0, 0); } } \
        if (((t) & 3) == 3) { \
            _Pragma("unroll") for (int m = 0; m < 4; ++m) _Pragma("unroll") for (int j = 0; j < 2; ++j) { const u32x2 sg = sgr[m][j]; const float i255 = 1.0f / 255.0f; \
                ys[m][2 * j][0] += acc[m][2 * j][0] * ((float)(sg.x & 255u) * i255); ys[m][2 * j][1] += acc[m][2 * j][1] * ((float)((sg.x >> 8) & 255u) * i255); ys[m][2 * j][2] += acc[m][2 * j][2] * ((float)((sg.x >> 16) & 255u) * i255); ys[m][2 * j][3] += acc[m][2 * j][3] * ((float)(sg.x >> 24) * i255); \
                ys[m][2 * j + 1][0] += acc[m][2 * j + 1][0] * ((float)(sg.y & 255u) * i255); ys[m][2 * j + 1][1] += acc[m][2 * j + 1][1] * ((float)((sg.y >> 8) & 255u) * i255); ys[m][2 * j + 1][2] += acc[m][2 * j + 1][2] * ((float)((sg.y >> 16) & 255u) * i255); ys[m][2 * j + 1][3] += acc[m][2 * j + 1][3] * ((float)(sg.y >> 24) * i255); \
                acc[m][2 * j] = (f32x4){0.f, 0.f, 0.f, 0.f}; acc[m][2 * j + 1] = (f32x4){0.f, 0.f, 0.f, 0.f}; } } \
        if ((t) + 1 < 16) MRG_STORE(((t) + 1) & 1, q); \
        __syncthreads(); } while (0)
    for (int k4 = 0; k4 < 16; k4 += 4) { MRG_STEP(k4, 1); MRG_STEP(k4 + 1, 0); MRG_STEP(k4 + 2, 1); MRG_STEP(k4 + 3, 0); }
#undef MRG_STEP
    bf16* YB = WSP(bf16, O_H); const int row0 = pm * 128 + wr * 64 + fr, col0 = pn * 256 + wc * 64 + 8 * fq;
#pragma unroll
    for (int m = 0; m < 4; ++m)
#pragma unroll
        for (int j = 0; j < 2; ++j) *(u32x4*)(YB + (size_t)(row0 + 16 * m) * DM + col0 + 32 * j) = (u32x4){pk2(ys[m][2 * j][0], ys[m][2 * j][1]), pk2(ys[m][2 * j][2], ys[m][2 * j][3]), pk2(ys[m][2 * j + 1][0], ys[m][2 * j + 1][1]), pk2(ys[m][2 * j + 1][2], ys[m][2 * j + 1][3])};
#undef MRG_LOADA
#undef MRG_LOADB
#undef MRG_STORE
}

__device__ __forceinline__ void rg_conv_unit(CArgs& A, int l, int n) {
    const int tid = tidx(); const bf16* PM = WSP(bf16, O_PM); bf16* XC = WSP(bf16, O_XC); const int r0 = n * 64; int s0, s1; seq_bounds(n, s0, s1);
    const int c0 = (tid & 31) * 8, tq = tid >> 5; float wc[4][8];
#pragma unroll
    for (int k = 0; k < 4; ++k) { const float* wp = A.in[I_RWC] + (l * 4 + k) * 256 + c0; const f32x4 a = *(const f32x4*)wp, b = *(const f32x4*)(wp + 4);
        wc[k][0] = a[0]; wc[k][1] = a[1]; wc[k][2] = a[2]; wc[k][3] = a[3]; wc[k][4] = b[0]; wc[k][5] = b[1]; wc[k][6] = b[2]; wc[k][7] = b[3]; }
    u32x4 xr[4][4];
#pragma unroll
    for (int i = 0; i < 4; ++i)
#pragma unroll
        for (int k = 0; k < 4; ++k) { const int rr = r0 + tq + 16 * i + k - 2; const int rc = min(max(rr, s0), s1 - 1); const u32x4 v = *(const u32x4*)(PM + (size_t)rc * PMC + 2048 + c0);
            xr[i][k] = (rr >= s0 && rr < s1) ? v : (u32x4){0u, 0u, 0u, 0u}; }
#pragma unroll
    for (int i = 0; i < 4; ++i) { float o[8];
#pragma unroll
        for (int e = 0; e < 8; ++e) o[e] = 0.f;
#pragma unroll
        for (int k = 0; k < 4; ++k) { const u32x4 x = xr[i][k];
            o[0] += wc[k][0] * bflo(x.x); o[1] += wc[k][1] * bfhi(x.x); o[2] += wc[k][2] * bflo(x.y); o[3] += wc[k][3] * bfhi(x.y);
            o[4] += wc[k][4] * bflo(x.z); o[5] += wc[k][5] * bfhi(x.z); o[6] += wc[k][6] * bflo(x.w); o[7] += wc[k][7] * bfhi(x.w); }
        *(u32x4*)(XC + (size_t)(r0 + tq + 16 * i) * 256 + c0) = (u32x4){pk2(o[0], o[1]), pk2(o[2], o[3]), pk2(o[4], o[5]), pk2(o[6], o[7])}; }
}
struct EpiRG {
    static constexpr bool PERM = true;
    const bf16* XC; bf16* LA; bf16* BT; const float* ba; const float* bx; const float* sp;
    __device__ __forceinline__ void operator()(const f32x4 (&acc)[2][2][4][2], const Unit& u, int wr, int wc, int fr, int fq) const {
        const int d = u.pn >> 1, ch0 = (u.pn & 1) * 128 + wc * 32 + 8 * fq, row0 = u.pm * 256 + wr * 64 + fr;
#pragma unroll
        for (int ai = 0; ai < 2; ++ai)
#pragma unroll
            for (int n = 0; n < 2; ++n) { const int cc = d * 256 + ch0 + 4 * n;
                const f32x4 bav = *(const f32x4*)(ba + cc), bxv = *(const f32x4*)(bx + cc), spv = *(const f32x4*)(sp + cc); u32x2 xw[4];
#pragma unroll
                for (int m = 0; m < 4; ++m) xw[m] = *(const u32x2*)(XC + (size_t)(row0 + ai * 128 + m * 16) * 256 + ch0 + 4 * n);
#pragma unroll
                for (int m = 0; m < 4; ++m) { const int row = row0 + ai * 128 + m * 16; const size_t o = ((size_t)d * TT + row) * 256 + ch0;
                    const float xc[4] = {bflo(xw[m].x), bfhi(xw[m].x), bflo(xw[m].y), bfhi(xw[m].y)}; float la[4], bt[4];
#pragma unroll
                    for (int e = 0; e < 4; ++e) { const float r = sigmoid_fast(acc[ai][0][m][n][e] + bav[e]), ig = sigmoid_fast(acc[ai][1][m][n][e] + bxv[e]);
                        la[e] = -8.0f * r * spv[e]; const float a = __expf(la[e]); bt[e] = sqrtf(fmaxf(1.0f - a * a, 0.f)) * ig * xc[e]; }
                    *(u32x2*)(LA + o + 4 * n) = (u32x2){pk2(la[0], la[1]), pk2(la[2], la[3])};
                    *(u32x2*)(BT + o + 4 * n) = (u32x2){pk2(bt[0], bt[1]), pk2(bt[2], bt[3])}; }
                asm volatile("" ::: "memory"); }
    }
};
template <bool OUT>
__device__ __forceinline__ void rg_scan_unit(CArgs& A, LAS unsigned char* lds, int l, int n) {
    const int tid = tidx(); LAS float* sY = (LAS float*)lds; const int r0 = n * 64, ch = tid & 255, d = tid >> 8;
    const bf16* LA = WSP(bf16, O_RLA) + ((size_t)d * TT + r0) * 256 + ch; const bf16* BT = WSP(bf16, O_RBT) + ((size_t)d * TT + r0) * 256 + ch;
    float* RGP = WSP(float, O_RGP); float* RGH = WSP(float, O_RGH); const int cix = (d * NCHK + n) * 256 + ch;
    u32x4 gtr[4];
    if (OUT) { const bf16* PMg = WSP(bf16, O_PM) + (size_t)(r0 + (tid >> 5)) * PMC + 2304 + (tid & 31) * 8;
#pragma unroll
        for (int i = 0; i < 4; ++i) gtr[i] = *(const u32x4*)(PMg + (size_t)(16 * i) * PMC); }
    float h = OUT ? RGH[cix] : 0.f, lsum = 0.f;
    const int stp = d ? -256 : 256;
    for (int hb = 0; hb < 2; ++hb) { const int t0 = d ? 63 - 32 * hb : 32 * hb; bf16 lav[32], btv[32];
#pragma unroll
        for (int q = 0; q < 32; ++q) { lav[q] = LA[t0 * 256 + q * stp]; btv[q] = BT[t0 * 256 + q * stp]; }
#pragma unroll
        for (int q = 0; q < 32; ++q) { const float la = bf2f(lav[q]); h = __expf(la) * h + bf2f(btv[q]); lsum += la;
            if (OUT) { LAS float* yp = sY + t0 * 256 + q * stp + ch; if (hb == 0) *yp = h; else *yp += h; } }
        if (OUT) __syncthreads(); }
    if (!OUT) { RGP[cix] = __expf(lsum); RGH[cix] = h; }
    else { bf16* BR3 = WSP(bf16, O_BR) + (size_t)3 * TT * 256; const int c0 = (tid & 31) * 8;
#pragma unroll
        for (int i = 0; i < 4; ++i) { const int t = (tid >> 5) + 16 * i; const LAS f32x4* yp = (const LAS f32x4*)(sY + t * 256 + c0); const f32x4 y0 = yp[0], y1 = yp[1]; const u32x4 g = gtr[i];
            *(u32x4*)(BR3 + (size_t)(r0 + t) * 256 + c0) = (u32x4){pk2(y0[0] * gelu_tanh(bflo(g.x)), y0[1] * gelu_tanh(bfhi(g.x))), pk2(y0[2] * gelu_tanh(bflo(g.y)), y0[3] * gelu_tanh(bfhi(g.y))),
                                                                   pk2(y1[0] * gelu_tanh(bflo(g.z)), y1[1] * gelu_tanh(bfhi(g.z))), pk2(y1[2] * gelu_tanh(bflo(g.w)), y1[3] * gelu_tanh(bfhi(g.w)))}; }
        __syncthreads(); }
}
__device__ __forceinline__ void rg_carry(CArgs& A, int e) {
    const float* RGP = WSP(float, O_RGP); float* RGH = WSP(float, O_RGH);
    const int ch = e & 255, d = (e >> 8) & 1, b = e >> 9; float s = 0.f;
    for (int st = 0; st < 132; st += 22) { float tmp[22], pp[22]; int ix[22];
#pragma unroll
        for (int q = 0; q < 22; ++q) { ix[q] = (d * NCHK + seq_chunk(b, d, st + q)) * 256 + ch; tmp[q] = RGH[ix[q]]; pp[q] = RGP[ix[q]]; }
#pragma unroll
        for (int q = 0; q < 22; ++q) { RGH[ix[q]] = s; s = pp[q] * s + tmp[q]; } }
}
__device__ __forceinline__ void s5_carry(CArgs& A, int l, int e) {
    const int p = e & 63, d = (e >> 6) & 1, g = (e >> 7) & 15, b = e >> 11;
    const f32x2 w64 = WSP(f32x2, O_S5PW)[(size_t)(((l * 16 + g) * 2 + d) * 65 + 64) * 64 + p]; const float wr_ = w64.x, wi_ = w64.y;
    const float* HC = WSP(float, O_HC) + (size_t)g * 768 * 256; bf16* UH = WSP(bf16, O_UH) + (size_t)g * 768 * 1280;
    float sr = 0.f, si = 0.f;
    for (int st = 0; st < 132; st += 22) { float hr[22], hi[22]; int nn[22];
#pragma unroll
        for (int q = 0; q < 22; ++q) { nn[q] = seq_chunk(b, d, st + q); hr[q] = HC[(size_t)nn[q] * 256 + d * 128 + p]; hi[q] = HC[(size_t)nn[q] * 256 + d * 128 + 64 + p]; }
#pragma unroll
        for (int q = 0; q < 22; ++q) { UH[(size_t)nn[q] * 1280 + 1024 + d * 128 + p] = (bf16)f2bf(sr); UH[(size_t)nn[q] * 1280 + 1024 + d * 128 + 64 + p] = (bf16)f2bf(si);
            const float t = wr_ * sr - wi_ * si + hr[q]; si = wr_ * si + wi_ * sr + hi[q]; sr = t; } }
}

__device__ __forceinline__ void hy_pre_unit(CArgs& A, LAS unsigned char* lds, int l, int n) {
    const int tid = tidx(); LAS float* sZ = (LAS float*)lds; const bf16* PM = WSP(bf16, O_PM);
    const int r0 = n * 64; int s0, s1; seq_bounds(n, s0, s1); const int c0 = (tid & 31) * 8, tq = tid >> 5;
    float wv[3][8], w1[3][8];
#pragma unroll
    for (int k = 0; k < 3; ++k) { const float* wp = A.in[I_HWS] + (l * 3 + k) * 768 + c0; const f32x4 a = *(const f32x4*)wp, b = *(const f32x4*)(wp + 4), c = *(const f32x4*)(wp + 512), d = *(const f32x4*)(wp + 516);
        wv[k][0] = a[0]; wv[k][1] = a[1]; wv[k][2] = a[2]; wv[k][3] = a[3]; wv[k][4] = b[0]; wv[k][5] = b[1]; wv[k][6] = b[2]; wv[k][7] = b[3];
        w1[k][0] = c[0]; w1[k][1] = c[1]; w1[k][2] = c[2]; w1[k][3] = c[3]; w1[k][4] = d[0]; w1[k][5] = d[1]; w1[k][6] = d[2]; w1[k][7] = d[3]; }
    u32x4 xa[4][3], xb[4][3];
#pragma unroll
    for (int i = 0; i < 4; ++i)
#pragma unroll
        for (int k = 0; k < 3; ++k) { const int rr = r0 + tq + 16 * i + k - 1; const bool ok = rr >= s0 && rr < s1; const int rc = min(max(rr, s0), s1 - 1);
            const u32x4 a = *(const u32x4*)(PM + (size_t)rc * PMC + 1280 + c0), b = *(const u32x4*)(PM + (size_t)rc * PMC + 1792 + c0);
            xa[i][k] = ok ? a : (u32x4){0u, 0u, 0u, 0u}; xb[i][k] = ok ? b : (u32x4){0u, 0u, 0u, 0u}; }
#pragma unroll
    for (int i = 0; i < 4; ++i) { const int t = tq + 16 * i; float pv[8], p1[8];
#pragma unroll
        for (int e = 0; e < 8; ++e) { pv[e] = 0.f; p1[e] = 0.f; }
#pragma unroll
        for (int k = 0; k < 3; ++k) { const u32x4 a = xa[i][k], b = xb[i][k];
            pv[0] += wv[k][0] * bflo(a.x); pv[1] += wv[k][1] * bfhi(a.x); pv[2] += wv[k][2] * bflo(a.y); pv[3] += wv[k][3] * bfhi(a.y); pv[4] += wv[k][4] * bflo(a.z); pv[5] += wv[k][5] * bfhi(a.z); pv[6] += wv[k][6] * bflo(a.w); pv[7] += wv[k][7] * bfhi(a.w);
            p1[0] += w1[k][0] * bflo(b.x); p1[1] += w1[k][1] * bfhi(b.x); p1[2] += w1[k][2] * bflo(b.y); p1[3] += w1[k][3] * bfhi(b.y); p1[4] += w1[k][4] * bflo(b.z); p1[5] += w1[k][5] * bfhi(b.z); p1[6] += w1[k][6] * bflo(b.w); p1[7] += w1[k][7] * bfhi(b.w); }
        if (n < 512) {
#pragma unroll
            for (int e = 0; e < 8; ++e) sZ[(c0 + e) * 65 + t] = p1[e] * pv[e]; }
        else { float* zp = WSP(float, O_ZC) + (size_t)(r0 - TL + t) * 256 + c0;
            *(f32x4*)zp = (f32x4){p1[0] * pv[0], p1[1] * pv[1], p1[2] * pv[2], p1[3] * pv[3]}; *(f32x4*)(zp + 4) = (f32x4){p1[4] * pv[4], p1[5] * pv[5], p1[6] * pv[6], p1[7] * pv[7]}; } }
    if (n < 512) { __syncthreads(); const int b = n >> 7, t0 = (n & 127) * 64; float* ZT = WSP(float, O_ZT);
        for (int idx = tid; idx < 256 * 16; idx += NTHR) { const int cc = idx >> 4, seg = idx & 15; const LAS float* sp = sZ + cc * 65 + seg * 4;
            *(f32x4*)(ZT + ((size_t)(b * 256 + cc)) * 8192 + t0 + seg * 4) = (f32x4){sp[0], sp[1], sp[2], sp[3]}; } }
    __syncthreads();
}
__host__ __device__ constexpr float c32(int k) { constexpr float t[16] = {1.0f, 0.98078528040323f, 0.92387953251129f, 0.83146961230255f, 0.70710678118655f, 0.55557023301960f, 0.38268343236509f, 0.19509032201613f,
    0.0f, -0.19509032201613f, -0.38268343236509f, -0.55557023301960f, -0.70710678118655f, -0.83146961230255f, -0.92387953251129f, -0.98078528040323f}; return t[k]; }
__host__ __device__ constexpr float s32(int k) { constexpr float t[16] = {0.0f, 0.19509032201613f, 0.38268343236509f, 0.55557023301960f, 0.70710678118655f, 0.83146961230255f, 0.92387953251129f, 0.98078528040323f,
    1.0f, 0.98078528040323f, 0.92387953251129f, 0.83146961230255f, 0.70710678118655f, 0.55557023301960f, 0.38268343236509f, 0.19509032201613f}; return t[k]; }
__host__ __device__ constexpr int brev(int p, int L) { int r = 0; for (int i = 0; i < L; ++i) r |= ((p >> i) & 1) << (L - 1 - i); return r; }
template <int L, bool CONJ> __device__ __forceinline__ void dif_regs(f32x2 (&v)[1 << L]) {
    constexpr int n = 1 << L;
#pragma unroll
    for (int s = 0; s < L; ++s) {
#pragma unroll
        for (int i = 0; i < n / 2; ++i) { const int half = n >> (s + 1), grp = i / half, k = i % half, i0 = grp * 2 * half + k, i1 = i0 + half, tw = (k << s) * (32 / n);
            const f32x2 a = v[i0], b = v[i1]; v[i0] = a + b; const f32x2 d = a - b; const float c = c32(tw), sn = s32(tw);
            if (tw == 0) v[i1] = d;
            else v[i1] = CONJ ? (f32x2){d.x * c - d.y * sn, d.y * c + d.x * sn} : (f32x2){d.x * c + d.y * sn, d.y * c - d.x * sn}; } }
}
__device__ __forceinline__ int fphys(int i) { return i + (i >> 4) + ((i >> 9) << 4); }
template <bool CONJ> __device__ __forceinline__ f32x2 tw_mul(const f32x2 v, float r) {
    const float c = __builtin_amdgcn_cosf(r), sn = __builtin_amdgcn_sinf(r);
    return CONJ ? (f32x2){v.x * c - v.y * sn, v.y * c + v.x * sn} : (f32x2){v.x * c + v.y * sn, v.y * c - v.x * sn};
}
#define FFT_SB() __builtin_amdgcn_sched_barrier(0)
__device__ __forceinline__ void fft_fwd16k(f32x2 (&v)[32], LAS f32x2* X, const f32x2* TW, int tid) {
    dif_regs<5, false>(v);
    { LAS f32x2* XA = X + tid + (tid >> 4); float tf = (float)tid; asm volatile("" : "+v"(tf));
#pragma unroll
      for (int p = 0; p < 32; ++p) { const int k1 = brev(p, 5); XA[k1 * 560] = tw_mul<false>(v[p], tf * ((float)k1 * (1.0f / 16384.0f))); if ((p & 7) == 7) FFT_SB(); } }
    __syncthreads();
    { const int k1 = tid >> 4, m2 = tid & 15; LAS f32x2* XB = X + k1 * 560 + m2; float mf = (float)m2; asm volatile("" : "+v"(mf));
#pragma unroll
      for (int m1 = 0; m1 < 32; ++m1) v[m1] = XB[m1 * 17];
      FFT_SB();
      dif_regs<5, false>(v);
      FFT_SB();
#pragma unroll
      for (int p = 0; p < 32; ++p) { const int q1 = brev(p, 5); XB[q1 * 17] = tw_mul<false>(v[p], mf * ((float)q1 * (1.0f / 512.0f))); if ((p & 7) == 7) FFT_SB(); } }
    __syncthreads();
#pragma unroll
    for (int gi = 0; gi < 2; ++gi) { const int g = 2 * tid + gi; LAS f32x2* XC = X + g * 17 + ((g >> 5) << 4); f32x2 u[16];
#pragma unroll
        for (int m = 0; m < 16; ++m) u[m] = XC[m];
        dif_regs<4, false>(u);
#pragma unroll
        for (int m = 0; m < 16; ++m) v[gi * 16 + m] = u[m];
        FFT_SB(); }
}
__device__ __forceinline__ void fft_inv16k(f32x2 (&v)[32], LAS f32x2* X, const f32x2* TW, int tid) {
#pragma unroll
    for (int gi = 0; gi < 2; ++gi) { const int g = 2 * tid + gi; LAS f32x2* XC = X + g * 17 + ((g >> 5) << 4); f32x2 u[16];
#pragma unroll
        for (int q = 0; q < 16; ++q) u[q] = v[gi * 16 + brev(q, 4)];
        dif_regs<4, true>(u);
#pragma unroll
        for (int p = 0; p < 16; ++p) XC[brev(p, 4)] = u[p];
        FFT_SB(); }
    __syncthreads();
    { const int k1 = tid >> 4, m2 = tid & 15; LAS f32x2* XB = X + k1 * 560 + m2; float mf = (float)m2; asm volatile("" : "+v"(mf));
#pragma unroll
      for (int q1 = 0; q1 < 32; ++q1) { v[q1] = tw_mul<true>(XB[q1 * 17], mf * ((float)q1 * (1.0f / 512.0f))); if ((q1 & 7) == 7) FFT_SB(); }
      dif_regs<5, true>(v);
      FFT_SB();
#pragma unroll
      for (int p = 0; p < 32; ++p) XB[brev(p, 5) * 17] = v[p]; }
    __syncthreads();
    { LAS f32x2* XA = X + tid + (tid >> 4); float tf = (float)tid; asm volatile("" : "+v"(tf));
#pragma unroll
      for (int k1 = 0; k1 < 32; ++k1) { v[k1] = tw_mul<true>(XA[k1 * 560], tf * ((float)k1 * (1.0f / 16384.0f))); if ((k1 & 7) == 7) FFT_SB(); } }
    dif_regs<5, true>(v);
}
__device__ __forceinline__ void hy_fft_unit(CArgs& A, LAS unsigned char* lds, int l, int c) {
    const int tid = tidx(), lane = tid & 63, wave = tid >> 6; LAS f32x2* X = (LAS f32x2*)lds; LAS float* sN = (LAS float*)(lds + 143360);
    const f32x2* TW = WSP(f32x2, O_TW); const float* HF = WSP(float, O_HFIL) + (size_t)l * 512 * 8192; const float* HPS = WSP(float, O_HPS) + (size_t)l * 512 * 128;
    const float* hf = HF + (size_t)c * 8192; const float* hb = HF + (size_t)(c + 256) * 8192;
    f32x2 v[32]; float hb0 = 0.f;
    { const unsigned ut = (unsigned)tid;
#pragma unroll
      for (int n1 = 0; n1 < 16; ++n1) v[n1] = (f32x2){(hf + n1 * 512)[ut], 0.f};
      if (tid == 0) hb0 = hb[0];
#pragma unroll
      for (int n1 = 16; n1 < 32; ++n1) { const float hv = (n1 == 16 && tid == 0) ? 0.f : (hb + 16384 - n1 * 512)[-(int)ut]; v[n1] = (f32x2){hv, 0.f}; } }
    if (wave < 2) { const float* p = HPS + (size_t)(c + 256 * wave) * 128; const float s = wave_sum(p[lane] + p[lane + 64]); if (lane == 0) sN[wave] = 1.0f / (s + EPS); }
    __syncthreads();
    { const float nf = sN[0], nb = sN[1];
#pragma unroll
      for (int n1 = 0; n1 < 16; ++n1) v[n1].x *= nf;
      v[0].x += hb0 * nb;
#pragma unroll
      for (int n1 = 16; n1 < 32; ++n1) v[n1].x *= nb; }
    fft_fwd16k(v, X, TW, tid);
    f32x2* GS = WSP(f32x2, O_GS) + (size_t)bidx() * 16384;
    { const unsigned ut = (unsigned)tidx();
#pragma unroll
      for (int i = 0; i < 32; ++i) (GS + i * 512)[ut] = v[i]; }
    const float* ZT = WSP(float, O_ZT); float* CZ = WSP(float, O_CZT); const float bias = A.in[I_HBIAS][l * 256 + c];
    for (int pr = 0; pr < 2; ++pr) {
        const float* z0 = ZT + ((size_t)((2 * pr) * 256 + c)) * 8192; const float* z1 = ZT + ((size_t)((2 * pr + 1) * 256 + c)) * 8192;
        float* c0 = CZ + ((size_t)((2 * pr) * 256 + c)) * 8192; float* c1 = CZ + ((size_t)((2 * pr + 1) * 256 + c)) * 8192;
        __syncthreads();
        { const unsigned ut = (unsigned)tidx();
#pragma unroll
          for (int n1 = 0; n1 < 16; ++n1) { v[n1] = (f32x2){(z0 + n1 * 512)[ut], (z1 + n1 * 512)[ut]}; v[n1 + 16] = (f32x2){0.f, 0.f}; } }
        fft_fwd16k(v, X, TW, tid);
        { const unsigned ut = (unsigned)tidx();
#pragma unroll
          for (int i = 0; i < 32; ++i) { const f32x2 x = v[i]; const unsigned long long gw = __hip_atomic_load((const unsigned long long*)((GS + i * 512) + ut), __ATOMIC_RELAXED, __HIP_MEMORY_SCOPE_AGENT);
            const float gx = __uint_as_float((unsigned)gw), gy = __uint_as_float((unsigned)(gw >> 32)); v[i] = (f32x2){x.x * gx - x.y * gy, x.x * gy + x.y * gx}; if ((i & 7) == 7) FFT_SB(); } }
        fft_inv16k(v, X, TW, tid);
        { const unsigned ut = (unsigned)tidx(); float zr0[16], zr1[16];
#pragma unroll
          for (int n1 = 0; n1 < 16; ++n1) { zr0[n1] = (z0 + n1 * 512)[ut]; zr1[n1] = (z1 + n1 * 512)[ut]; }
#pragma unroll
          for (int p = 0; p < 32; ++p) { const int n1 = brev(p, 5); if (n1 < 16) {
            (c0 + n1 * 512)[ut] = v[p].x * (1.0f / 16384.0f) + zr0[n1] * bias; (c1 + n1 * 512)[ut] = v[p].y * (1.0f / 16384.0f) + zr1[n1] * bias; } } }
    }
    __syncthreads();
}
__device__ __forceinline__ void hy_ctx_conv_half(CArgs& A, LAS unsigned char* lds, int l, int u, int hsel) {
    const int tid = tidx(), b = u >> 3, c0 = (u & 7) * 32 + hsel * 16;
    constexpr int HP = 545;
    LAS float* sZ = (LAS float*)lds; LAS float* sH = sZ + 256 * 17; LAS float* sN = sH + 16 * HP;
    const float* ZC = WSP(float, O_ZC) + (size_t)b * 256 * 256; const float* HF = WSP(float, O_HFILC); const float* PS = WSP(float, O_HPSC);
    if (tid < 32) { const int ch = (tid < 16 ? 0 : 256) + c0 + (tid & 15); sN[tid] = 1.0f / (PS[ch * 4] + PS[ch * 4 + 1] + PS[ch * 4 + 2] + PS[ch * 4 + 3] + EPS); }
    for (int idx = tid; idx < 4096; idx += NTHR) { const int s = idx >> 4, cc = idx & 15; sZ[s * 17 + cc] = ZC[(size_t)s * 256 + c0 + cc]; }
    __syncthreads();
    for (int idx = tid; idx < 16 * 528; idx += NTHR) { const int cc = idx / 528, k = idx - cc * 528, d = k - 264; float v = 0.f;
        if (d >= 0 && d <= 255) v += HF[(size_t)(c0 + cc) * 256 + d] * sN[cc];
        if (d <= 0 && d >= -255) v += HF[(size_t)(256 + c0 + cc) * 256 - d] * sN[16 + cc];
        sH[cc * HP + k] = v; }
    __syncthreads();
    const int cc = tid & 15, t0 = (tid >> 4) * 8; float acc[8];
#pragma unroll
    for (int j = 0; j < 8; ++j) acc[j] = 0.f;
    const LAS float* hp = sH + cc * HP + 264 + t0 - 7; const LAS float* zp = sZ + cc;
    for (int sb = 0; sb < 32; ++sb) { float f[15], z[8];
#pragma unroll
        for (int k = 0; k < 15; ++k) f[k] = hp[k - 8 * sb];
#pragma unroll
        for (int q = 0; q < 8; ++q) z[q] = zp[(8 * sb + q) * 17];
#pragma unroll
        for (int j = 0; j < 8; ++j)
#pragma unroll
            for (int q = 0; q < 8; ++q) acc[j] += f[j - q + 7] * z[q]; }
    float* CZ = WSP(float, O_CZC) + (size_t)b * 256 * 256; const float bias = A.in[I_HBIAS][l * 256 + c0 + cc];
#pragma unroll
    for (int j = 0; j < 8; ++j) CZ[(size_t)(t0 + j) * 256 + c0 + cc] = acc[j] + zp[(t0 + j) * 17] * bias;
    __syncthreads();
}
__device__ __forceinline__ void hy_ctx_conv_unit(CArgs& A, LAS unsigned char* lds, int l, int u, int hsel) {
    if (hsel < 0) { hy_ctx_conv_half(A, lds, l, u, 0); hy_ctx_conv_half(A, lds, l, u, 1); } else hy_ctx_conv_half(A, lds, l, u, hsel);
}
__device__ __forceinline__ void hy_out_unit(CArgs& A, LAS unsigned char* lds, int l, int n) {
    const int tid = tidx(); LAS float* sZ = (LAS float*)lds; const bf16* PM = WSP(bf16, O_PM);
    const int r0 = n * 64; int s0, s1; seq_bounds(n, s0, s1); const int c = tid & 255, half = tid >> 8, tb = half * 32;
    float w0[3]; bf16 xr[34];
#pragma unroll
    for (int k = 0; k < 3; ++k) w0[k] = A.in[I_HWS][(l * 3 + k) * 768 + 256 + c];
#pragma unroll
    for (int q = 0; q < 34; ++q) { const int rr = r0 + tb + q - 1; const int rc = min(max(rr, s0), s1 - 1); xr[q] = PM[(size_t)rc * PMC + 1536 + c]; }
    if (n < 512) { const int b = n >> 7, t0 = (n & 127) * 64; const float* ZT = WSP(float, O_CZT);
        for (int idx = tid; idx < 256 * 16; idx += NTHR) { const int cc = idx >> 4, seg = idx & 15; const f32x4 v = *(const f32x4*)(ZT + ((size_t)(b * 256 + cc)) * 8192 + t0 + seg * 4); LAS float* s = sZ + cc * 65 + seg * 4; s[0] = v[0]; s[1] = v[1]; s[2] = v[2]; s[3] = v[3]; }
        __syncthreads(); }
    bf16* BR2 = WSP(bf16, O_BR) + (size_t)2 * TT * 256;
    { float xv[34], czv[32];
#pragma unroll
        for (int q = 0; q < 34; ++q) { const int rr = r0 + tb + q - 1; xv[q] = (rr >= s0 && rr < s1) ? bf2f(xr[q]) : 0.f; }
#pragma unroll
        for (int q = 0; q < 32; ++q) czv[q] = n < 512 ? sZ[c * 65 + tb + q] : WSP(float, O_CZC)[(size_t)(r0 - TL + tb + q) * 256 + c];
#pragma unroll
        for (int q = 0; q < 32; ++q) BR2[(size_t)(r0 + tb + q) * 256 + c] = (bf16)f2bf((w0[0] * xv[q] + w0[1] * xv[q + 1] + w0[2] * xv[q + 2]) * czv[q]); }
    __syncthreads();
}

struct ConvItem { const float* src; unsigned char* dst; int N, ldk; };
__device__ __forceinline__ ConvItem moe_conv_item(CArgs& A, int it, int lane) {
    constexpr int I_G = 16 * 112, I_D = 56 * 16; const int e = it / (I_G + I_D); int r = it % (I_G + I_D); ConvItem c;
    if (r < I_G) { const int kb = r / 112, nb = r % 112; c.N = 2 * DEX; c.ldk = DM; c.src = A.in[I_MGU] + (size_t)e * DM * 2 * DEX + (size_t)(kb * 64 + (lane >> 4)) * c.N + nb * 64 + 4 * (lane & 15);
        c.dst = WSP(unsigned char, O_MWGU) + (size_t)e * 2 * DEX * DM + (size_t)swiglu_dest(nb * 64, DEX) * DM + kb * 64; }
    else { r -= I_G; const int kb = r / 16, nb = r % 16; c.N = DM; c.ldk = DEX; c.src = A.in[I_MDN] + (size_t)e * DEX * DM + (size_t)(kb * 64 + (lane >> 4)) * c.N + nb * 64 + 4 * (lane & 15);
        c.dst = WSP(unsigned char, O_MWDN) + (size_t)e * DM * DEX + (size_t)(nb * 64) * DEX + kb * 64; }
    return c;
}
__device__ __forceinline__ void moe_convert_weights(CArgs& A, LAS unsigned char* lds) {
    const int tid = tidx(), lane = tid & 63, wave = tid >> 6; const int gw = bidx() * NWAVE + wave, NGW = gdim() * NWAVE;
    LAS float* scr = (LAS float*)(lds + wave * 17408);
    constexpr int NITEM = NEX * (16 * 112 + 56 * 16);
    f32x4 v[16], vn[16]; ConvItem cur, nxt;
    int it = gw; if (it >= NITEM) return;
    cur = moe_conv_item(A, it, lane);
#pragma unroll
    for (int i = 0; i < 16; ++i) v[i] = __builtin_nontemporal_load((const f32x4*)(cur.src + (size_t)(4 * i) * cur.N));
    for (;;) {
        const int itn = it + NGW; const bool more = itn < NITEM;
        if (more) { nxt = moe_conv_item(A, itn, lane);
#pragma unroll
            for (int i = 0; i < 16; ++i) vn[i] = __builtin_nontemporal_load((const f32x4*)(nxt.src + (size_t)(4 * i) * nxt.N)); }
#pragma unroll
        for (int i = 0; i < 16; ++i) { LAS float* d = scr + (4 * i + (lane >> 4)) * 65 + 4 * (lane & 15); d[0] = v[i][0]; d[1] = v[i][1]; d[2] = v[i][2]; d[3] = v[i][3]; }
        asm volatile("s_waitcnt lgkmcnt(0)" ::: "memory");
        { const int kg = lane & 3;
#pragma unroll
          for (int q = 0; q < 4; ++q) { const int n = (lane >> 2) + 16 * q; const LAS float* s = scr + (16 * kg) * 65 + n;
            u32x4 o; o.x = pack4_fp8(32.f * s[0], 32.f * s[65], 32.f * s[130], 32.f * s[195]); o.y = pack4_fp8(32.f * s[260], 32.f * s[325], 32.f * s[390], 32.f * s[455]);
            o.z = pack4_fp8(32.f * s[520], 32.f * s[585], 32.f * s[650], 32.f * s[715]); o.w = pack4_fp8(32.f * s[780], 32.f * s[845], 32.f * s[910], 32.f * s[975]);
            *(u32x4*)(cur.dst + (size_t)n * cur.ldk + 16 * kg) = o; } }
        asm volatile("s_waitcnt lgkmcnt(0)" ::: "memory");
        if (!more) break;
        it = itn; cur = nxt;
#pragma unroll
        for (int i = 0; i < 16; ++i) v[i] = vn[i];
    }
}
#ifndef CONV_PROBE
#define CONV_PROBE 0
#endif
__device__ __forceinline__ void moe_convert_loads_only(CArgs& A) {
    const int tid = tidx(), lane = tid & 63, wave = tid >> 6; const int gw = bidx() * NWAVE + wave, NGW = gdim() * NWAVE;
    constexpr int I_G = 16 * 112, I_D = 56 * 16;
    for (int it = gw; it < NEX * (I_G + I_D); it += NGW) { const int e = it / (I_G + I_D); int r = it % (I_G + I_D); const float* W; int N, k0, n0;
        if (r < I_G) { W = A.in[I_MGU] + (size_t)e * DM * 2 * DEX; N = 2 * DEX; k0 = (r / 112) * 64; n0 = (r % 112) * 64; } else { r -= I_G; W = A.in[I_MDN] + (size_t)e * DEX * DM; N = DM; k0 = (r / 16) * 64; n0 = (r % 16) * 64; }
        const int tiles_n = N / 256; const int q = r; const int kb16 = q / tiles_n, nb256 = q % tiles_n; (void)k0; (void)n0;
        const float* src = W + (size_t)(kb16 * 16) * N + nb256 * 256 + 4 * lane; f32x4 v[16];
#pragma unroll
        for (int i = 0; i < 16; ++i) v[i] = __builtin_nontemporal_load((const f32x4*)(src + (size_t)i * N));
#pragma unroll
        for (int i = 0; i < 16; ++i) asm volatile("" :: "v"(v[i])); }
}
__device__ __forceinline__ void moe_bases(const unsigned* ctl, int s, int (&tb)[9]) {
    int acc = 0;
#pragma unroll
    for (int e = 0; e < 8; ++e) { tb[e] = acc; const unsigned c = __hip_atomic_load(ctl + CW_CNT + s * 8 + e, __ATOMIC_RELAXED, __HIP_MEMORY_SCOPE_AGENT); acc += (int)((c + 255u) >> 8); }
    tb[8] = acc;
}
__device__ __forceinline__ void ph_moe_scatter(CArgs& A, LAS unsigned char* lds) {
    const int tid = tidx(), lane = tid & 63, wave = tid >> 6, G = gdim(), bx = bidx(); const int tpb = TL / G;
    unsigned* ctl = WSP(unsigned, O_CTL);
    LAS unsigned* sB = (LAS unsigned*)lds;
    LAS unsigned* sTot = sB + 4096; LAS unsigned* sRun = sTot + 16; LAS unsigned* sBase = sRun + 16;
    for (int i = tid; i < G * 16; i += NTHR) sB[i] = __hip_atomic_load(ctl + CW_BLK + i, __ATOMIC_RELAXED, __HIP_MEMORY_SCOPE_AGENT);
    __syncthreads();
    if (tid < 16) { unsigned tot = 0, pre = 0; for (int b = 0; b < G; ++b) { const unsigned c = sB[b * 16 + tid]; tot += c; pre += (b < bx) ? c : 0u; } sTot[tid] = tot; sRun[tid] = pre; }
    __syncthreads();
    if (tid < 2) { unsigned acc = 0; for (int e = 0; e < 8; ++e) { sBase[tid * 8 + e] = acc * 256u; acc += (sTot[tid * 8 + e] + 255u) >> 8; } }
    __syncthreads();
    if (tid < 16) { sRun[tid] += sBase[tid]; if (bx == 0) ctl[CW_CNT + tid] = sTot[tid]; }
    __syncthreads();
    int* RT = WSP(int, O_RTOK); float* RW = WSP(float, O_RW); const bf16* H = WSP(bf16, O_H); bf16* H2S = WSP(bf16, O_H2S);
    if (bx == 0) {
        for (int j = 0; j < 16; ++j) { const int s = j >> 3, base = (int)sBase[j], cnt = (int)sTot[j], end = base + (int)(((sTot[j] + 255u) >> 8) << 8);
            for (int i = base + cnt + tid; i < end; i += NTHR) RT[s * MOE_ROWS + i] = -1; } }
    for (int it = 0; it * NWAVE < tpb; ++it) { const int t = bx * tpb + wave + it * NWAVE;
        const u32x4 ti = WSP(u32x4, O_TOKI)[t];
        int p0 = 0, p1 = 0;
        if (lane == 0) { p0 = (int)__hip_atomic_fetch_add(sRun + ti.x, 1u, __ATOMIC_RELAXED, __HIP_MEMORY_SCOPE_WORKGROUP); p1 = (int)__hip_atomic_fetch_add(sRun + 8 + ti.y, 1u, __ATOMIC_RELAXED, __HIP_MEMORY_SCOPE_WORKGROUP);
            RT[p0] = t; RW[p0] = __uint_as_float(ti.z); RT[MOE_ROWS + p1] = t; RW[MOE_ROWS + p1] = __uint_as_float(ti.w); WSP(u32x2, O_TPOS)[t] = (u32x2){(unsigned)p0, (unsigned)(MOE_ROWS + p1)}; }
        p0 = __shfl(p0, 0); p1 = __shfl(p1, 0);
        const u32x4 a = ((const u32x4*)((const unsigned char*)H + (size_t)t * DM))[lane];
        ((u32x4*)((unsigned char*)H2S + (size_t)p0 * DM))[lane] = a; ((u32x4*)((unsigned char*)H2S + ((size_t)MOE_ROWS + p1) * DM))[lane] = a;
    }
    __syncthreads();
}
__device__ __forceinline__ void ph_final(CArgs& A) {
    const int lane = tidx() & 63, wave = tidx() >> 6; const int gw = bidx() * NWAVE + wave, NGW = gdim() * NWAVE;
    const bf16* DL = WSP(bf16, O_H2S); const u32x2* TP = WSP(u32x2, O_TPOS); const bf16* XB = WSP(bf16, O_XB);
    f32x4 fg[4];
#pragma unroll
    for (int j = 0; j < 4; ++j) fg[j] = ((const f32x4*)A.in[I_FING])[lane + 64 * j];
#define FIN_LD(s_, k_) do { const int r_ = rb + (k_) * NGW; const unsigned t0_ = (unsigned)__shfl((int)tpl.x, (k_)), t1_ = (unsigned)__shfl((int)tpl.y, (k_)); \
        const u32x2* xr_ = (const u32x2*)(XB + (size_t)r_ * DM); const u32x2* d0_ = (const u32x2*)(DL + (size_t)t0_ * DM); const u32x2* d1_ = (const u32x2*)(DL + (size_t)t1_ * DM); \
        _Pragma("unroll") for (int j = 0; j < 4; ++j) { raw[s_][j] = xr_[lane + 64 * j]; raw[s_][4 + j] = d0_[lane + 64 * j]; raw[s_][8 + j] = d1_[lane + 64 * j]; } } while (0)
#define FIN_DO(s_, k_) do { const int r_ = rb + (k_) * NGW; f32x4* p_ = (f32x4*)(A.out + (size_t)r_ * DM); f32x4 v[4]; float ss = 0.f; \
        _Pragma("unroll") for (int j = 0; j < 4; ++j) { const u32x2 xw = raw[s_][j], a = raw[s_][4 + j], b = raw[s_][8 + j]; \
            v[j] = (f32x4){bflo(xw.x) + (bflo(a.x) + bflo(b.x)), bfhi(xw.x) + (bfhi(a.x) + bfhi(b.x)), bflo(xw.y) + (bflo(a.y) + bflo(b.y)), bfhi(xw.y) + (bfhi(a.y) + bfhi(b.y))}; \
            ss += (v[j][0] * v[j][0] + v[j][1] * v[j][1]) + (v[j][2] * v[j][2] + v[j][3] * v[j][3]); } \
        const float rstd = 1.0f / sqrtf(wave_sum(ss) * (1.0f / DM) + EPS); \
        _Pragma("unroll") for (int j = 0; j < 4; ++j) p_[lane + 64 * j] = v[j] * rstd * fg[j]; } while (0)
    for (int rb = gw; rb < TL; rb += 64 * NGW) {
        u32x2 tpl = (u32x2){0u, 0u}; { const int rl = rb + lane * NGW; if (rl < TL) tpl = TP[rl]; }
        int nr = (TL - rb + NGW - 1) / NGW; if (nr > 64) nr = 64;
        u32x2 raw[2][12];
        FIN_LD(0, 0);
        for (int k = 0; k < nr; k += 2) {
            if (k + 1 < nr) FIN_LD(1, k + 1);
            FIN_DO(0, k);
            if (k + 1 < nr) { if (k + 2 < nr) FIN_LD(0, k + 2); FIN_DO(1, k + 1); }
        }
    }
#undef FIN_LD
#undef FIN_DO
}

#ifndef PHMASK
#define PHMASK 0xFFFFFFFFu
#endif
#define EN(j) ((PHMASK >> (j)) & 1u)
#ifndef UMASK
#define UMASK 0xFu
#endif
#define UEN(j) ((UMASK >> (j)) & 1u)
#define IN(k) (lo <= (k) && (k) < hi)
#ifndef DUPBAR
#define DUPBAR 0
#endif
#define SEAM(k) do { if (IN(k) && IN((k) + 1)) { xcd_barrier(bar); if (DUPBAR) xcd_barrier(bar); } } while (0)
#ifndef DUPMASK
#define DUPMASK 0u
#endif
#define DUP(j) for (int _r = 0; _r < (((DUPMASK >> (j)) & 1u) ? 2 : 1); ++_r)
#ifndef F8_SP2
#define F8_SP2 true
#endif
#define PH_LOCALS CArgs& A = KA; const int G = gdim(), bx = bidx(); (void)G; (void)bx
template <int l>
__device__ __forceinline__ void layer_body(LAS unsigned char* lds, const XcdBarrier& bar, int lo, int hi) {
    constexpr int P = 1 + 12 * l;
    if (EN(0) && IN(P + 0)) { { PH_LOCALS; for (int u = bx; u < 256; u += G) s5_fill_unit(A, l, u); } { PH_LOCALS; DUP(6) ph_norm(A, lds, l, 0, l == 0, false); } }
    SEAM(P + 0);
    if (EN(1) && IN(P + 1)) {
        PH_LOCALS;
        pg8::Gemm g{WSP(bf16, O_H), WSP(bf16, O_WIN) + (size_t)l * NINP * DM, DM, DM, DM}; pg8::StaticOrder S; S.init(NRT, NINP / 256, G, bx);
        EpiInProj E{WSP(bf16, O_PM), WSP(unsigned char, O_SG), WSP(bf16, O_GDN), WSP(bf16, O_UH)};
        DUP(14) pg8::gemm_phase(lds, g, S, E);
    }
    SEAM(P + 1);
    if (EN(2) && IN(P + 2)) {
        { PH_LOCALS; pg8::Gemm g{WSP(bf16, O_UH), WSP(bf16, O_BPOW), 1280, 1024, 1024}; OneUnit S; S.has = bx < 48; S.u.pa = bx; S.u.pb = bx / 3; S.u.pm = bx % 3; S.u.pn = 0; S.u.aux = bx / 3;
          EpiF32 E{WSP(float, O_HC), 256}; pg8::gemm_phase(lds, g, S, E); }
        { PH_LOCALS; constexpr int nhy = l == 0 ? NCHK : 512, NU = 2112 + NCHK + nhy;
          const int nA = (G > 48 && bx >= 48) ? 3 : 0, poolA = G > 48 ? 3 * (G - 48) : 0;
          for (int i = 0;; ++i) { const int u = i < nA ? (bx - 48) * 3 + i : poolA + bx + (i - nA) * G; if (u >= NU) break;
            if (u < 2112) { DUP(2) gla_local_unit(A, lds, l, u >> 2, u & 3); }
            else if (u < 2112 + NCHK) { DUP(3) rg_conv_unit(A, l, u - 2112); }
            else hy_pre_unit(A, lds, l, u - 2112 - NCHK);
          } }
    }
    SEAM(P + 2);
    if (EN(3) && IN(P + 3)) {
        { PH_LOCALS; for (int u = bx; u < 256; u += G) hy_fft_unit(A, lds, l, u); }
        { PH_LOCALS; pg8::Gemm g{WSP(bf16, O_XC), WSP(bf16, O_WRG) + (size_t)l * 1024 * 256, 256, 256, 256}; pg8::StaticOrder S; S.init(NRT, 4, G, bx);
          EpiRG E{WSP(bf16, O_XC), WSP(bf16, O_RLA), WSP(bf16, O_RBT), A.in[I_RBA] + l * 512, A.in[I_RBX] + l * 512, WSP(float, O_RGSP) + l * 512}; pg8::gemm_phase(lds, g, S, E); }
        { PH_LOCALS; gla_carry(A); }
        { PH_LOCALS; const int e = (G - 1 - bx) * NTHR + tidx(); if (e < 8192) s5_carry(A, l, e); }
    }
    SEAM(P + 3);
    if (EN(4) && IN(P + 4)) {
        { PH_LOCALS; pg8::Gemm g{WSP(bf16, O_UH), WSP(bf16, O_TCM), 1280, 1280, 1280}; OneUnit S; constexpr bool LASTL = l == 1; const bool noctx = LASTL && G == 256;
          S.has = bx < (noctx ? 128 : 192); const int gg = noctx ? bx >> 3 : bx / 12, pm = noctx ? (bx >> 2) & 1 : (bx % 12) >> 2, pn = bx & 3;
          S.u.pa = gg * 3 + pm; S.u.pb = gg * 4 + pn; S.u.pm = pm; S.u.pn = pn; S.u.aux = gg;
          EpiS5Y E{WSP(bf16, O_GBUF)}; pg8::gemm_phase(lds, g, S, E); }
        { PH_LOCALS; const bool ctxh = l == 0 && G == 256;
          if (ctxh && bx >= 192) hy_ctx_conv_unit(A, lds, l, (bx - 192) >> 1, (bx - 192) & 1);
          const bool noctx = l == 1 && G == 256; const int NGO = noctx ? 2048 : 2112, NB = noctx ? 128 : 192;
          const int NU = NGO + NCHK + ((l == 0 && !ctxh) ? 32 : 0);
          const int nX = ctxh ? 2 : 3;
          const int nA = (G > NB && bx >= NB) ? nX : 0, poolA = G > NB ? nX * (G - NB) : 0;
          for (int i = 0;; ++i) { const int u = i < nA ? (bx - NB) * nX + i : poolA + bx + (i - nA) * G; if (u >= NU) break;
            if (u < NGO) { DUP(2) gla_out_unit(A, lds, l, u >> 2, u & 3); }
            else if (u < NGO + NCHK) { DUP(3) rg_scan_unit<false>(A, lds, l, u - NGO); }
            else hy_ctx_conv_unit(A, lds, l, u - NGO - NCHK, -1);
          } }
    }
    SEAM(P + 4);
    if (EN(5) && IN(P + 5)) {
        { PH_LOCALS; const int rb = G >= 256 ? G - 133 - bx : G - 1 - bx; const int e = rb * NTHR + tidx(); if (rb >= 0 && e < 2048) rg_carry(A, e); }
        { PH_LOCALS; pg8::Gemm g{WSP(bf16, O_GBUF), WSP(bf16, O_WGLU) + (size_t)l * 65536, 256, 256, 256}; pg8::StaticOrder S; S.init((l == 1 && G == 256) ? 128 : NRT, 1, G, G >= 256 ? (bx + 132) % G : bx);
          EpiGlu E{WSP(bf16, O_GBUF), WSP(bf16, O_BR) + (size_t)TT * 256, A.in[I_BGLU] + l * 256}; pg8::gemm_phase(lds, g, S, E); }
        { PH_LOCALS; constexpr int NU = l == 0 ? NCHK : 512;
          for (int u = bx; u < NU; u += G) hy_out_unit(A, lds, l, u); }
    }
    SEAM(P + 5);
    if (EN(6) && IN(P + 6)) { PH_LOCALS; for (int u = bx; u < ((l == 1 && G == 256) ? 512 : NCHK); u += G) { DUP(3) rg_scan_unit<true>(A, lds, l, u); } }
    SEAM(P + 6);
    if (EN(7) && IN(P + 7)) {
        PH_LOCALS; constexpr int NU = (l == 0 ? TT : TL) / 128 * 4;
        const int vb = (G % 8 == 0) ? (bx % 8) * (G / 8) + bx / 8 : bx;
        for (int u = vb; u < NU; u += G) DUP(1) merge_unit(A, lds, l, u >> 2, u & 3);
    }
    SEAM(P + 7);
    if (EN(8) && IN(P + 8)) {
        PH_LOCALS;
        pg8::Gemm g{WSP(bf16, O_H), WSP(bf16, O_WOUT) + (size_t)l * 1024 * 1024, DM, DM, DM}; SplitOrder S; S.G = G; S.c = (G % 8 == 0) ? (bx % 8) * (G / 8) + bx / 8 : bx; S.U = (l == 0 ? NRT : TL / 256) * 4; S.KT = DM / 64; S.pa0 = 0; S.moe = 0; S.smax = 1;
        EpiResid E{WSP(bf16, O_XB), WSP(float, O_MODS) + (size_t)l * 5 * 6144 + 2 * 1024, 1.0f}; pg8::gemm_phase(lds, g, S, E);
#if (DUPMASK >> 11) & 1
        { EpiResid E0 = E; E0.sc = 0.f; pg8::gemm_phase(lds, g, S, E0); }
#endif

    }
    SEAM(P + 8);
    if (EN(9) && IN(P + 9)) { if (l == 1) { PH_LOCALS; moe_convert_weights(A, lds); }
#if (DUPMASK >> 10) & 1
        { PH_LOCALS; moe_convert_weights(A, lds); }
#endif
#if CONV_PROBE
        { PH_LOCALS; moe_convert_loads_only(A); }
#endif
        { PH_LOCALS; if (l == 0) { DUP(6) ph_norm(A, lds, l, 1, false, false); } else ph_norm(A, lds, l, 1, false, true); } }
    SEAM(P + 9);
    if constexpr (l == 0) {
        if (EN(10) && IN(P + 10)) { PH_LOCALS; pg8::Gemm g{WSP(bf16, O_H), WSP(bf16, O_WGU), DM / 2, DM / 2, DM / 2}; pg8::StaticOrder S; S.init(NRT, 2 * DFF / 256, G, bx);
            EpiSwiGLU8 E{WSP(unsigned char, O_FMID), DFF}; DUP(0) pg8::gemm_phase<EpiSwiGLU8, pg8::StaticOrder, true, true, F8_SP2>(lds, g, S, E); }
        SEAM(P + 10);
        if (EN(11) && IN(P + 11)) { PH_LOCALS; pg8::Gemm g{WSP(bf16, O_FMID), WSP(bf16, O_WDN), DFF / 2, DFF / 2, DFF / 2}; SplitOrder S; S.G = G; S.c = (G % 8 == 0) ? (bx % 8) * (G / 8) + bx / 8 : bx; S.U = NRT * 4; S.KT = DFF / 128; S.pa0 = 0; S.moe = 0; S.smax = 1;
            EpiResid E{WSP(bf16, O_XB), WSP(float, O_MODS) + (size_t)l * 5 * 6144 + 5 * 1024, 1.0f / 128.0f}; pg8::gemm_phase<EpiResid, SplitOrder, true, true, F8_SP2>(lds, g, S, E);
#if (DUPMASK >> 12) & 1
            { EpiResid E0 = E; E0.sc = 0.f; pg8::gemm_phase<EpiResid, SplitOrder, true, true, F8_SP2>(lds, g, S, E0); }
#endif
            }
        SEAM(P + 11);
    } else {
        if (EN(12) && IN(P + 10)) { PH_LOCALS; ph_moe_scatter(A, lds); }
        SEAM(P + 10);
        if (EN(13) && IN(P + 11)) { PH_LOCALS; Moe2Order S; S.G = G; S.c = bx; S.nN = 2 * DEX / 256; moe_bases(WSP(unsigned, O_CTL), 0, S.tb0); moe_bases(WSP(unsigned, O_CTL), 1, S.tb1);
            pg8::Gemm g{WSP(bf16, O_H2S), WSP(bf16, O_MWGU), DM / 2, DM / 2, DM / 2}; EpiSwiGLU8 E{WSP(unsigned char, O_MMID), DEX}; pg8::gemm_phase<EpiSwiGLU8, Moe2Order, true, true, F8_SP2>(lds, g, S, E); }
        SEAM(P + 11);
        if (EN(14) && IN(P + 12)) { PH_LOCALS; Moe2Order S; S.G = G; S.c = (G % 8 == 0) ? (bx % 8) * (G / 8) + bx / 8 : bx; S.nN = 4; moe_bases(WSP(unsigned, O_CTL), 0, S.tb0); moe_bases(WSP(unsigned, O_CTL), 1, S.tb1);
            pg8::Gemm g{WSP(bf16, O_MMID), WSP(bf16, O_MWDN), DEX / 2, DEX / 2, DEX / 2};
            EpiMoeDelta E{WSP(bf16, O_H2S), WSP(float, O_MODS) + (size_t)l * 5 * 6144 + 5 * 1024, WSP(int, O_RTOK), WSP(float, O_RW), 1.0f / 128.0f}; pg8::gemm_phase<EpiMoeDelta, Moe2Order, true, true, F8_SP2>(lds, g, S, E); }
        SEAM(P + 12);
    }
}
constexpr int N_PHASES = 27;
__global__ void __launch_bounds__(NTHR, 2) fwd_kernel(Args A_unused) {
    extern __shared__ __attribute__((aligned(16))) unsigned char lds_raw[];
    LAS unsigned char* lds = (LAS unsigned char*)lds_raw;
    volatile LAS unsigned* MISC = (volatile LAS unsigned*)(lds + LDS_MISC);
    if (tidx() < 16) MISC[tidx()] = 0u;
    __syncthreads();
    int lo, hi; XcdBarrier bar;
    { CArgs& A = KA; lo = A.ph_lo; hi = A.ph_hi; unsigned* ctl = WSP(unsigned, O_CTL);
      bar.bar = ctl + CW_BAR; bar.x = 0; bar.st = MISC + 8;
      if (hi - lo > 1) bar = xcd_barrier_post(ctl + CW_BAR, MISC + 8); }
    if (EN(16) && IN(0)) { { PH_LOCALS; ph_prologue(A, lds); }
#if (DUPMASK >> 9) & 1
        __syncthreads(); { PH_LOCALS; ph_prologue(A, lds); }
#endif
    }
    SEAM(0);
    layer_body<0>(lds, bar, lo, hi);
    layer_body<1>(lds, bar, lo, hi);
    if (EN(17) && IN(26)) { PH_LOCALS; ph_final(A); }
}

#ifndef MK_PER_PHASE
#define MK_PER_PHASE 0
#endif
extern "C" void kernel_launch(void* const* d_in, const int* in_sizes, int n_in, void* d_out, int out_size, void* d_ws, size_t ws_size, hipStream_t stream) {
    static int grid = 0;
    if (grid == 0) {
        if (n_in != 44 || out_size != TL * DM || ws_size < WS_END) { fprintf(stderr, "kernel_launch: unexpected problem (n_in %d, out %d, ws %zu < %zu)\n", n_in, out_size, ws_size, (size_t)WS_END); grid = -1; return; }
        int dev = 0, cus = 0, per_cu = 0;
        if (hipGetDevice(&dev) != hipSuccess || hipDeviceGetAttribute(&cus, hipDeviceAttributeMultiprocessorCount, dev) != hipSuccess) { grid = -1; return; }
        if (hipFuncSetAttribute((const void*)fwd_kernel, hipFuncAttributeMaxDynamicSharedMemorySize, LDS_BYTES) != hipSuccess) { fprintf(stderr, "kernel_launch: hipFuncSetAttribute failed\n"); grid = -1; return; }
        if (hipOccupancyMaxActiveBlocksPerMultiprocessor(&per_cu, (const void*)fwd_kernel, NTHR, LDS_BYTES) != hipSuccess || per_cu < 1) { fprintf(stderr, "kernel_launch: occupancy query says %d\n", per_cu); }
        (void)hipGetLastError();
        grid = cus;
    }
    if (grid < 0) return;
    (void)hipMemsetAsync((char*)d_ws + O_CTL, 0, SZ_CTL, stream);
    Args a{};
    for (int i = 0; i < 44; ++i) a.in[i] = (const float*)d_in[i];
    a.out = (float*)d_out; a.ws = (unsigned char*)d_ws;
#if MK_PER_PHASE
    for (int p = 0; p < N_PHASES; ++p) { a.ph_lo = p; a.ph_hi = p + 1; hipLaunchKernelGGL(fwd_kernel, dim3(grid), dim3(NTHR), LDS_BYTES, stream, a); }
#else
    a.ph_lo = 0; a.ph_hi = N_PHASES; hipLaunchKernelGGL(fwd_kernel, dim3(grid), dim3(NTHR), LDS_BYTES, stream, a);
#endif
}
```
